# Optimizing an MI355X kernel written in HIP

```python
import jax, jax.numpy as jnp
from jax import lax
import numpy as np

D_MODEL = 1024
BATCH = 32
SEQ = 2048
DEPTH = 2
DEC_BATCH = 16
DEC_SEQ = 2048
PAST_LEN = 128

GRID_W = 64
ROPE_THETA = 10000.0
EPS = 1e-6
NEG = -1e30
Q_BLOCK = 128
HEAD_DIM = 64
N_BRANCH = 4
BRANCH_W = 256
A_HEADS = 4
A_NOPE = 64
A_ROPE = 32
A_V = 64
A_Q_LORA = 256
A_KV_LORA = 128
A_IN = A_Q_LORA + A_KV_LORA + A_ROPE
B_HEADS = 4
B_KV = 2
B_IN = (B_HEADS + 2 * B_KV) * HEAD_DIM
C_HEADS = 4
C_KV = 2
C_WINDOW = 128
C_BLOCK = 128
C_IN = (C_HEADS + 2 * C_KV) * HEAD_DIM
D_HEADS = 4
D_KV = 2
D_GROUPS = ((128, 1), (512, 4), (2048, 16))
D_BLOCK = 64
D_GROUP_IN = (D_HEADS + 2 * D_KV) * HEAD_DIM
D_IN = len(D_GROUPS) * D_GROUP_IN
GATE_IN = N_BRANCH * BRANCH_W
MERGE_IN = N_BRANCH * D_MODEL
N_IN = A_IN + B_IN + C_IN + D_IN + GATE_IN + MERGE_IN

kernel_name = "hybrid_gated_parallel_encoder"


def _split_cols(a, sizes):
    idx, acc = [], 0
    for s in sizes[:-1]:
        acc += s
        idx.append(acc)
    return jnp.split(a, idx, axis=-1)


def _rms_norm(x, g):
    xf = x.astype(jnp.float32)
    y = xf * lax.rsqrt(jnp.mean(xf * xf, axis=-1, keepdims=True) + EPS)
    return (y * g.astype(jnp.float32)).astype(x.dtype)


def _rope(x, pos):
    d = x.shape[-1]
    half = d // 2
    freqs = ROPE_THETA ** (-jnp.arange(half, dtype=jnp.float32) * 2.0 / d)
    ang = pos.astype(jnp.float32)[:, None] * freqs[None, :]
    ang = ang.reshape((ang.shape[0],) + (1,) * (x.ndim - 3) + (half,))
    cos, sin = jnp.cos(ang), jnp.sin(ang)
    xf = x.astype(jnp.float32)
    x1, x2 = xf[..., :half], xf[..., half:]
    return jnp.concatenate([x1 * cos - x2 * sin, x1 * sin + x2 * cos], axis=-1).astype(x.dtype)


def _axial_rope(x, rows, cols):
    half = x.shape[-1] // 2
    return jnp.concatenate([_rope(x[..., :half], rows), _rope(x[..., half:], cols)], axis=-1)


def _dense_attention(q, k, v, scale):
    bn, t = q.shape[:2]
    nb = t // Q_BLOCK
    qb = jnp.moveaxis(q.reshape((bn, nb, Q_BLOCK) + q.shape[2:]), 1, 0)

    def one(qblk):
        s = jnp.einsum('bqhgd,bkhd->bhgqk', qblk, k, preferred_element_type=jnp.float32) * scale
        p = jax.nn.softmax(s, axis=-1)
        return jnp.einsum('bhgqk,bkhd->bqhgd', p.astype(v.dtype), v)

    o = lax.map(one, qb)
    return jnp.moveaxis(o, 0, 1).reshape((bn, t) + o.shape[3:])


def _banded_attention(q, k, v, window, block, scale):
    bn, length = q.shape[:2]
    nb = -(-length // block)
    lp = nb * block
    qp = jnp.pad(q, ((0, 0), (0, lp - length)) + ((0, 0),) * (q.ndim - 2))
    kpad = ((0, 0), (block, lp - length + block), (0, 0), (0, 0))
    kb = jnp.pad(k, kpad).reshape((bn, nb + 2, block) + k.shape[2:])
    vb = jnp.pad(v, kpad).reshape((bn, nb + 2, block) + v.shape[2:])
    kw = jnp.concatenate([kb[:, :-2], kb[:, 1:-1], kb[:, 2:]], axis=2)
    vw = jnp.concatenate([vb[:, :-2], vb[:, 1:-1], vb[:, 2:]], axis=2)
    qb = qp.reshape((bn, nb, block) + q.shape[2:])

    def one(args):
        qblk, kblk, vblk, i = args
        qpos = i * block + jnp.arange(block)
        kpos = (i - 1) * block + jnp.arange(3 * block)
        valid = (jnp.abs(qpos[:, None] - kpos[None, :]) <= window) & (kpos[None, :] >= 0) & (kpos[None, :] < length)
        s = jnp.einsum('bqhgd,bkhd->bhgqk', qblk, kblk, preferred_element_type=jnp.float32) * scale
        s = jnp.where(valid, s, NEG)
        lse = jax.nn.logsumexp(s, axis=-1)
        p = jnp.exp(s - lse[..., None])
        o = jnp.einsum('bhgqk,bkhd->bqhgd', p.astype(vblk.dtype), vblk)
        return o, jnp.moveaxis(lse, 3, 1)

    o, lse = lax.map(one, (jnp.moveaxis(qb, 1, 0), jnp.moveaxis(kw, 1, 0), jnp.moveaxis(vw, 1, 0), jnp.arange(nb)))
    o = jnp.moveaxis(o, 0, 1).reshape((bn, lp) + o.shape[3:])[:, :length]
    lse = jnp.moveaxis(lse, 0, 1).reshape((bn, lp) + lse.shape[3:])[:, :length]
    return o, lse


def _mla_mixer(h, pos, q_a_norm, w_q_up, kv_a_norm, w_kv_up):
    bn, t = h.shape[:2]
    q_lat, kv_lat, k_rope = _split_cols(h, [A_Q_LORA, A_KV_LORA, A_ROPE])
    q = (_rms_norm(q_lat, q_a_norm) @ w_q_up).reshape(bn, t, A_HEADS, A_NOPE + A_ROPE)
    kv = (_rms_norm(kv_lat, kv_a_norm) @ w_kv_up).reshape(bn, t, A_HEADS, A_NOPE + A_V)
    q = jnp.concatenate([q[..., :A_NOPE], _rope(q[..., A_NOPE:], pos)], axis=-1)
    k_r = _rope(k_rope[:, :, None, :], pos)
    k = jnp.concatenate([kv[..., :A_NOPE], jnp.broadcast_to(k_r, (bn, t, A_HEADS, A_ROPE))], axis=-1)
    v = kv[..., A_NOPE:]
    o = _dense_attention(q[:, :, :, None, :], k, v, (A_NOPE + A_ROPE) ** -0.5)
    return o.reshape(bn, t, A_HEADS * A_V)


def _axial_gqa_mixer(h, rows, cols, q_norm, k_norm):
    bn, t = h.shape[:2]
    q, k, v = _split_cols(h, [B_HEADS * HEAD_DIM, B_KV * HEAD_DIM, B_KV * HEAD_DIM])
    q = _axial_rope(_rms_norm(q.reshape(bn, t, B_HEADS, HEAD_DIM), q_norm), rows, cols)
    k = _axial_rope(_rms_norm(k.reshape(bn, t, B_KV, HEAD_DIM), k_norm), rows, cols)
    q = q.reshape(bn, t, B_KV, B_HEADS // B_KV, HEAD_DIM)
    v = v.reshape(bn, t, B_KV, HEAD_DIM)
    o = _dense_attention(q, k, v, HEAD_DIM ** -0.5)
    return o.reshape(bn, t, B_HEADS * HEAD_DIM)


def _sink_window_mixer(h, pos, sink):
    bn, t = h.shape[:2]
    g = C_HEADS // C_KV
    q, k, v = _split_cols(h, [C_HEADS * HEAD_DIM, C_KV * HEAD_DIM, C_KV * HEAD_DIM])
    q = _rope(q.reshape(bn, t, C_HEADS, HEAD_DIM), pos).reshape(bn, t, C_KV, g, HEAD_DIM)
    k = _rope(k.reshape(bn, t, C_KV, HEAD_DIM), pos)
    v = v.reshape(bn, t, C_KV, HEAD_DIM)
    o, lse = _banded_attention(q, k, v, C_WINDOW, C_BLOCK, HEAD_DIM ** -0.5)
    lse_tot = jnp.logaddexp(lse, sink.astype(jnp.float32).reshape(C_KV, g))
    o = o * jnp.exp(lse - lse_tot)[..., None].astype(o.dtype)
    return o.reshape(bn, t, C_HEADS * HEAD_DIM)


def _dilated_mixer(h, pos):
    bn, t = h.shape[:2]
    g = D_HEADS // D_KV
    outs, lses = [], []
    for gi, (window, dil) in enumerate(D_GROUPS):
        hg = h[..., gi * D_GROUP_IN:(gi + 1) * D_GROUP_IN]
        q, k, v = _split_cols(hg, [D_HEADS * HEAD_DIM, D_KV * HEAD_DIM, D_KV * HEAD_DIM])
        q = _rope(q.reshape(bn, t, D_HEADS, HEAD_DIM), pos).reshape(bn, t, D_KV, g, HEAD_DIM)
        k = _rope(k.reshape(bn, t, D_KV, HEAD_DIM), pos)
        v = v.reshape(bn, t, D_KV, HEAD_DIM)

        def to_strided(a, dil=dil):
            rest = a.shape[2:]
            a = a.reshape((bn, t // dil, dil) + rest)
            return jnp.moveaxis(a, 2, 1).reshape((bn * dil, t // dil) + rest)

        def from_strided(a, dil=dil):
            rest = a.shape[2:]
            a = a.reshape((bn, dil, t // dil) + rest)
            return jnp.moveaxis(a, 1, 2).reshape((bn, t) + rest)

        o, lse = _banded_attention(to_strided(q), to_strided(k), to_strided(v), window // (2 * dil), D_BLOCK, HEAD_DIM ** -0.5)
        outs.append(from_strided(o))
        lses.append(from_strided(lse))
    w = jax.nn.softmax(jnp.stack(lses, axis=0), axis=0)
    o = jnp.einsum('nbthg,nbthgd->bthgd', w.astype(outs[0].dtype), jnp.stack(outs, axis=0))
    return o.reshape(bn, t, D_HEADS * HEAD_DIM)


def _layer(x, pos, rows, cols, norm_g, w_in, a_q_norm, w_q_up, a_kv_norm, w_kv_up,
           b_q_norm, b_k_norm, c_sink, w_branch, w_out):
    bn, t = x.shape[:2]
    xn = _rms_norm(x, norm_g)
    h = xn @ w_in
    h_a, h_b, h_c, h_d, z, mg = _split_cols(h, [A_IN, B_IN, C_IN, D_IN, GATE_IN, MERGE_IN])
    ys = [
        _mla_mixer(h_a, pos, a_q_norm, w_q_up, a_kv_norm, w_kv_up),
        _axial_gqa_mixer(h_b, rows, cols, b_q_norm, b_k_norm),
        _sink_window_mixer(h_c, pos, c_sink),
        _dilated_mixer(h_d, pos),
    ]
    merged = jnp.zeros_like(x)
    for i in range(N_BRANCH):
        yi = ys[i] * jax.nn.silu(z[..., i * BRANCH_W:(i + 1) * BRANCH_W])
        gi = jax.nn.sigmoid(mg[..., i * D_MODEL:(i + 1) * D_MODEL])
        merged = merged + gi * (yi @ w_branch[i])
    return x + merged @ w_out


def _trunk(x, norm_in, w_in, a_q_norm, w_q_up, a_kv_norm, w_kv_up,
           b_q_norm, b_k_norm, c_sink, w_branch, w_out, final_norm):
    t = x.shape[1]
    rows_n = t // GRID_W
    pos = jnp.arange(t)
    rows = jnp.repeat(jnp.arange(rows_n), GRID_W)
    cols = jnp.tile(jnp.arange(GRID_W), rows_n)
    for l in range(DEPTH):
        x = _layer(x, pos, rows, cols, norm_in[l], w_in[l], a_q_norm[l], w_q_up[l], a_kv_norm[l], w_kv_up[l],
                   b_q_norm[l], b_k_norm[l], c_sink[l], w_branch[l], w_out[l])
    return _rms_norm(x, final_norm)


def setup_inputs(seed: int = 0) -> dict:
    key = jax.random.key(seed)
    ks = jax.random.split(key, 16)
    f = jnp.float32

    def gain(k, shape):
        return jnp.ones(shape, f) + 0.02 * jax.random.normal(k, shape, f)

    return {
        'x_prompt': jax.random.normal(ks[0], (BATCH, SEQ, D_MODEL), f),
        'x_sample': jax.random.normal(ks[1], (DEC_BATCH, DEC_SEQ, D_MODEL), f),
        'norm_in': gain(ks[2], (DEPTH, D_MODEL)),
        'w_in': jax.random.normal(ks[3], (DEPTH, D_MODEL, N_IN), f) * D_MODEL ** -0.5,
        'a_q_norm': gain(ks[4], (DEPTH, A_Q_LORA)),
        'w_q_up': jax.random.normal(ks[5], (DEPTH, A_Q_LORA, A_HEADS * (A_NOPE + A_ROPE)), f) * A_Q_LORA ** -0.5,
        'a_kv_norm': gain(ks[6], (DEPTH, A_KV_LORA)),
        'w_kv_up': jax.random.normal(ks[7], (DEPTH, A_KV_LORA, A_HEADS * (A_NOPE + A_V)), f) * A_KV_LORA ** -0.5,
        'b_q_norm': gain(ks[8], (DEPTH, HEAD_DIM)),
        'b_k_norm': gain(ks[9], (DEPTH, HEAD_DIM)),
        'c_sink': 0.5 * jax.random.normal(ks[10], (DEPTH, C_HEADS), f),
        'w_branch': jax.random.normal(ks[11], (DEPTH, N_BRANCH, BRANCH_W, D_MODEL), f) * BRANCH_W ** -0.5,
        'w_out': jax.random.normal(ks[12], (DEPTH, D_MODEL, D_MODEL), f) * D_MODEL ** -0.5,
        'final_norm': gain(ks[13], (D_MODEL,)),
    }


def reference(x_prompt, x_sample, norm_in, w_in, a_q_norm, w_q_up, a_kv_norm, w_kv_up,
              b_q_norm, b_k_norm, c_sink, w_branch, w_out, final_norm):
    y_prompt = _trunk(x_prompt, norm_in, w_in, a_q_norm, w_q_up, a_kv_norm, w_kv_up,
                      b_q_norm, b_k_norm, c_sink, w_branch, w_out, final_norm)
    y_sample = _trunk(x_sample, norm_in, w_in, a_q_norm, w_q_up, a_kv_norm, w_kv_up,
                      b_q_norm, b_k_norm, c_sink, w_branch, w_out, final_norm)
    return (y_prompt, y_sample)
```

```cpp
#include <hip/hip_runtime.h>
#include <hip/hip_cooperative_groups.h>
#include <cstdio>
namespace cg = cooperative_groups;

#define LAS __attribute__((address_space(3)))
#define DI __device__ __forceinline__
typedef unsigned short bf16_t;
typedef short bf16x8 __attribute__((ext_vector_type(8)));
typedef short s16x4 __attribute__((ext_vector_type(4)));
typedef float f32x4 __attribute__((ext_vector_type(4)));
typedef float f32x16 __attribute__((ext_vector_type(16)));
typedef unsigned u32x4 __attribute__((ext_vector_type(4)));
typedef unsigned u32x2 __attribute__((ext_vector_type(2)));
typedef float f32x2_t __attribute__((ext_vector_type(2)));
typedef __bf16 bf16x2_t __attribute__((ext_vector_type(2)));

DI unsigned cvtpk(float lo, float hi) { f32x2_t v = {lo, hi}; bf16x2_t b = __builtin_convertvector(v, bf16x2_t); return __builtin_bit_cast(unsigned, b); }
DI float bflo(unsigned w) { return __uint_as_float(w << 16); }
DI float bfhi(unsigned w) { return __uint_as_float(w & 0xffff0000u); }
DI float fexp2(float x) { return __builtin_amdgcn_exp2f(x); }
DI float sigmoidf_(float x) { return __builtin_amdgcn_rcpf(1.f + fexp2(-1.4426950408889634f * x)); }
DI u32x4 pack8(const float* v) { u32x4 w; w.x = cvtpk(v[0], v[1]); w.y = cvtpk(v[2], v[3]); w.z = cvtpk(v[4], v[5]); w.w = cvtpk(v[6], v[7]); return w; }

template <class Tp> DI Tp* launder(Tp* p) { unsigned long long v = (unsigned long long)p; asm volatile("" : "+s"(v)); return (Tp*)v; }
DI int launder(int v) { asm volatile("" : "+s"(v)); return v; }
DI int vlaunder(int v) { asm volatile("" : "+v"(v)); return v; }
DI int get_tid(int wv) { return launder(wv) * 64 + (int)__builtin_amdgcn_mbcnt_hi(~0u, __builtin_amdgcn_mbcnt_lo(~0u, (unsigned)vlaunder(0))); }
constexpr int NSUB = 4;
constexpr int T = 2048, DM = 1024, NSEQ = 48, NIN = 8096, PROMPT_ROWS = 32 * 2048;
constexpr float EPS = 1e-6f, LOG2E = 1.4426950408889634f;
constexpr float QS64 = 0.125f * LOG2E;
constexpr float QS96 = 0.10206207261596575f * LOG2E;
constexpr float INV2PI = 0.15915494309189535f;
constexpr float LOG2_THETA = 13.287712379549449f;

struct Params { const float* in[14]; float* out; unsigned char* ws; int spc; int nchunk; };

struct WS { size_t WinT, WmgT, WbT, WoutT, WupT, SSQ, XB, QB, KB, VB, QC, KC, VC, QD, KD, VD, LAT, ZS, QA, KA, VA, OD, LSE, P, YG, MRG, END; };
__host__ __device__ inline size_t al256(size_t x) { return (x + 255) & ~(size_t)255; }
__host__ __device__ inline WS make_ws(size_t Mc) {
    WS w; size_t o = 0;
    w.WinT = o; o += (size_t)2 * 4096 * 1024 * 2;
    w.WmgT = o; o += (size_t)2 * 4096 * 1024 * 2;
    w.WbT = o; o += (size_t)2 * 4 * 1024 * 256 * 2;
    w.WoutT = o; o += (size_t)2 * 1024 * 1024 * 2;
    w.WupT = o; o += (size_t)2 * 1024 * 384 * 2;
    w.SSQ = o; o += al256(Mc * 8 * 4);
    w.XB = o; o += Mc * 2048;
    size_t r0 = o;
    w.QB = o; o += Mc * 512; w.KB = o; o += Mc * 256; w.VB = o; o += Mc * 256;
    w.QC = o; o += Mc * 512; w.KC = o; o += Mc * 256; w.VC = o; o += Mc * 256;
    w.QD = o; o += Mc * 1536; w.KD = o; o += Mc * 768; w.VD = o; o += Mc * 768;
    w.LAT = o; o += Mc * 768; w.ZS = o; o += Mc * 2048;
    w.QA = o; o += Mc * 768; w.KA = o; o += Mc * 768; w.VA = o; o += Mc * 512;
    w.OD = o; o += Mc * 1536; w.LSE = o; o += Mc * 48;
    w.P = r0;
    if (o < r0 + Mc * 8192) o = r0 + Mc * 8192;
    o = al256(o);
    w.YG = o; o += Mc * 2048;
    w.MRG = o; o += Mc * 2048;
    w.END = o; return w;
}

namespace pg8 {
constexpr int BM = 256, BK = 64, HALF = 128, HTB = HALF * BK * 2, NXCD = 8, WGM = 8;
DI int lds_byte(int r, int c) { const int st = (r >> 4) * 2 + (c >> 5), rr = r & 15, cc = c & 31, ob = rr * 64 + cc * 2; return st * 1024 + (ob ^ (((ob >> 9) & 1) << 5)); }
DI void stage_rc(int b, int& R, int& C) { const int st = b / 1024, sb = b % 1024, swz = sb ^ (((sb >> 9) & 1) << 5); R = (st >> 1) * 16 + swz / 64; C = (st & 1) * 32 + (swz % 64) / 2; }
DI int perm32(int rho) { const int n = rho >> 4, i = rho & 15; return 8 * (i >> 2) + 4 * n + (i & 3); }

struct Unit { int pm, pn, grp; };
struct Gemm { const bf16_t* A; const bf16_t* Bt; int K; size_t gsA, gsB; };
struct Order {
    int lgN, nwg, ntot, G, c;
    DI void init(int M, int N, int ngrp_, int G_, int c_) { const int nM = M / BM, nN = N / BM; lgN = (nN == 16) ? 4 : 2; nwg = nM * nN; ntot = nwg * ngrp_; G = G_; c = c_; }
    DI bool next(int i, Unit& u) const {
        const int L = i * G + c; if (L >= ntot) return false;
        const int grp = (L >= nwg) + (L >= 2 * nwg) + (L >= 3 * nwg);
        int wgid = L - grp * nwg;
        wgid = (wgid & 7) * (nwg >> 3) + (wgid >> 3);
        const int gid = wgid >> (3 + lgN), rem = wgid & ((8 << lgN) - 1);
        u.pm = gid * 8 + (rem & 7); u.pn = rem >> 3; u.grp = grp; return true;
    }
};

template <class Epi>
DI void gemm_phase(int wv, LAS unsigned char* lds, const Gemm g, const Order& S, const Epi& E) {
    const int tid = get_tid(wv), wid = __builtin_amdgcn_readfirstlane(tid >> 6), lane = tid & 63, wr = wid >> 2, wc = wid & 3, fr = lane & 15, fq = lane >> 4;
    const int K = g.K, nt = K / BK;
    unsigned voffA[2], voffB[2];
#pragma unroll
    for (int i = 0; i < 2; ++i) { int R, C; stage_rc(tid * 16 + i * 8192, R, C); const int Rb = (R & ~31) + perm32(R & 31);
        voffA[i] = (unsigned)(R * K + C) * 2u; voffB[i] = (unsigned)(Rb * K + C) * 2u; }
    const size_t kstep = (size_t)(BK * 2);
    const size_t hstep = (size_t)HALF * K * 2;
    const size_t tstep = 2 * hstep;
    const unsigned ldsw = (unsigned)wid * 1024u;
    const int aoff = lds_byte(wr * 64 + fr, fq * 8), boff = lds_byte(wc * 32 + fr, fq * 8);
#define PG8_SA(b, h) (((b) * 2 + (h)) * HTB)
#define PG8_SB(b, h) ((4 + (b) * 2 + (h)) * HTB)
#define PG8_STAGE(bufoff, gbase, voff) do { _Pragma("unroll") for (int _i = 0; _i < 2; ++_i) \
        __builtin_amdgcn_global_load_lds((const unsigned*)((const char*)(gbase) + (voff)[_i]), (LAS unsigned*)(lds + (bufoff) + ldsw + _i * 8192), 16, 0, 0); } while (0)
#define PG8_LDA(dst, b, h) do { _Pragma("unroll") for (int m = 0; m < 4; ++m) _Pragma("unroll") for (int k = 0; k < 2; ++k) dst[m][k] = *(const LAS bf16x8*)(lds + PG8_SA(b, h) + aoff + m * 2048 + k * 1024); } while (0)
#define PG8_LDB(dst, b, h) do { _Pragma("unroll") for (int n = 0; n < 2; ++n) _Pragma("unroll") for (int k = 0; k < 2; ++k) dst[n][k] = *(const LAS bf16x8*)(lds + PG8_SB(b, h) + boff + n * 2048 + k * 1024); } while (0)
#define PG8_MMA(ai, bj, At, Bt) do { __builtin_amdgcn_s_setprio(1); _Pragma("unroll") for (int m = 0; m < 4; ++m) _Pragma("unroll") for (int n = 0; n < 2; ++n) _Pragma("unroll") for (int k = 0; k < 2; ++k) \
        acc[ai][bj][m][n] = __builtin_amdgcn_mfma_f32_16x16x32_bf16(Bt[n][k], At[m][k], acc[ai][bj][m][n], 0, 0, 0); __builtin_amdgcn_s_setprio(0); } while (0)
#define PG8_WAIT_V(n) asm volatile("s_waitcnt vmcnt(" #n ")" ::: "memory")
#define PG8_WAIT_L(n) asm volatile("s_waitcnt lgkmcnt(" #n ")" ::: "memory")
#define PG8_BAR __builtin_amdgcn_s_barrier()
#define PG8_SCHED __builtin_amdgcn_sched_barrier(0)
    Unit cur, nxt; int ui = 0;
    if (!S.next(0, cur)) return;
    f32x4 acc[2][2][4][2];
#pragma unroll
    for (int a = 0; a < 2; ++a)
#pragma unroll
        for (int b = 0; b < 2; ++b)
#pragma unroll
            for (int m = 0; m < 4; ++m)
#pragma unroll
                for (int n = 0; n < 2; ++n) acc[a][b][m][n] = (f32x4){0.f, 0.f, 0.f, 0.f};
    bf16x8 At[4][2], B0[2][2], B1[2][2];
    const char* cA = (const char*)g.A + (size_t)cur.grp * g.gsA + (size_t)cur.pm * tstep; const char* cB = (const char*)g.Bt + (size_t)cur.grp * g.gsB + (size_t)cur.pn * tstep;
    PG8_STAGE(PG8_SB(0, 0), cB, voffB); PG8_STAGE(PG8_SB(0, 1), cB + hstep, voffB); PG8_STAGE(PG8_SA(0, 0), cA, voffA); PG8_STAGE(PG8_SA(0, 1), cA + hstep, voffA);
    if (wr == 1) PG8_BAR;
    PG8_WAIT_V(2); PG8_BAR;
    PG8_STAGE(PG8_SB(1, 0), cB + kstep, voffB); PG8_STAGE(PG8_SA(1, 0), cA + kstep, voffA); PG8_STAGE(PG8_SB(1, 1), cB + hstep + kstep, voffB);
    PG8_WAIT_V(6); PG8_BAR;
    for (;;) {
        const bool has_next = S.next(ui + 1, nxt);
        const char* nA = has_next ? (const char*)g.A + (size_t)nxt.grp * g.gsA + (size_t)nxt.pm * tstep : cA;
        const char* nB = has_next ? (const char*)g.Bt + (size_t)nxt.grp * g.gsB + (size_t)nxt.pn * tstep : cB;
        for (int t = 0; t < nt; t += 2) {
            const bool last = (t == nt - 2);
            const char* a1 = cA + (size_t)(t + 1) * kstep;
            const char* a2 = last ? nA : cA + (size_t)(t + 2) * kstep; const char* b2 = last ? nB : cB + (size_t)(t + 2) * kstep;
            const char* a3 = a2 + kstep; const char* b3 = b2 + kstep;
            PG8_LDB(B0, 0, 0); PG8_LDB(B1, 0, 1); PG8_SCHED; PG8_LDA(At, 0, 0); PG8_STAGE(PG8_SA(1, 1), a1 + hstep, voffA);
            PG8_WAIT_V(8); PG8_WAIT_L(0); PG8_BAR; PG8_MMA(0, 0, At, B0); PG8_MMA(0, 1, At, B1); PG8_BAR; PG8_SCHED;
            PG8_LDA(At, 0, 1); PG8_STAGE(PG8_SB(0, 0), b2, voffB); PG8_STAGE(PG8_SB(0, 1), b2 + hstep, voffB); PG8_STAGE(PG8_SA(0, 0), a2, voffA);
            PG8_WAIT_V(8); PG8_WAIT_L(0); PG8_BAR; PG8_MMA(1, 0, At, B0); PG8_MMA(1, 1, At, B1); PG8_BAR; PG8_SCHED;
            PG8_LDB(B0, 1, 0); PG8_LDB(B1, 1, 1); PG8_SCHED; PG8_LDA(At, 1, 0); PG8_STAGE(PG8_SA(0, 1), a2 + hstep, voffA);
            PG8_WAIT_V(8); PG8_WAIT_L(0); PG8_BAR; PG8_MMA(0, 0, At, B0); PG8_MMA(0, 1, At, B1); PG8_BAR; PG8_SCHED;
            PG8_LDA(At, 1, 1); PG8_STAGE(PG8_SB(1, 0), b3, voffB); PG8_STAGE(PG8_SB(1, 1), b3 + hstep, voffB); PG8_STAGE(PG8_SA(1, 0), a3, voffA);
            PG8_WAIT_V(8); PG8_WAIT_L(0); PG8_BAR; PG8_MMA(1, 0, At, B0); PG8_MMA(1, 1, At, B1); PG8_BAR; PG8_SCHED;
        }
        if (wr == 0) PG8_BAR;
        E(acc, cur, wv);
        if (!has_next) break;
#pragma unroll
        for (int a = 0; a < 2; ++a)
#pragma unroll
            for (int b = 0; b < 2; ++b)
#pragma unroll
                for (int m = 0; m < 4; ++m)
#pragma unroll
                    for (int n = 0; n < 2; ++n) acc[a][b][m][n] = (f32x4){0.f, 0.f, 0.f, 0.f};
        cur = nxt; cA = nA; cB = nB; ++ui;
        if (wr == 1) PG8_BAR;
    }
    PG8_WAIT_V(0);
    PG8_BAR;
#undef PG8_SA
#undef PG8_SB
#undef PG8_STAGE
#undef PG8_LDA
#undef PG8_LDB
#undef PG8_MMA
#undef PG8_WAIT_V
#undef PG8_WAIT_L
#undef PG8_BAR
#undef PG8_SCHED
}
}
using pg8::Unit;
typedef f32x4 AccT[2][2][4][2];

DI void sincos_rev(float rev, float& c, float& s) { const float f = __builtin_amdgcn_fractf(rev); c = __builtin_amdgcn_cosf(f); s = __builtin_amdgcn_sinf(f); }
DI float shx(float v, int m) { return __shfl_xor(v, m, 64); }
#define EPI_LAUNDER() const int wid_ = launder(wv), wr = wid_ >> 2, wc = wid_ & 3; const int lane_ = (int)__builtin_amdgcn_mbcnt_hi(~0u, __builtin_amdgcn_mbcnt_lo(~0u, (unsigned)vlaunder(0))); const int fr = lane_ & 15, fq = lane_ >> 4

DI const float* row_ptr(const float* xa, const float* xb, size_t split, size_t R) { return (R < split) ? xa + R * 1024 : xb + (R - split) * 1024; }
struct Epi1 {
    unsigned char* ws0; const float *bqn, *bkn; size_t Mc;
    DI void operator()(const AccT& acc, const Unit& u, int wv) const {
        EPI_LAUNDER();
        unsigned char* ws = launder(ws0); const WS w = make_ws(Mc);
        bf16_t *QB = (bf16_t*)(ws + w.QB), *KB = (bf16_t*)(ws + w.KB), *VB = (bf16_t*)(ws + w.VB), *QC = (bf16_t*)(ws + w.QC), *KC = (bf16_t*)(ws + w.KC), *VC = (bf16_t*)(ws + w.VC);
        bf16_t *QD = (bf16_t*)(ws + w.QD), *KD = (bf16_t*)(ws + w.KD), *VD = (bf16_t*)(ws + w.VD), *LAT = (bf16_t*)(ws + w.LAT), *ZS = (bf16_t*)(ws + w.ZS), *KA = (bf16_t*)(ws + w.KA);
        float* SSQ = (float*)(ws + w.SSQ);
        const int pn = u.pn, rbase = u.pm * 256 + wr * 64 + fr;
        if (pn < 10) {
            const int br = pn >> 1, j = pn & 1;
            const bool isq = !j, isv = j && (wc >= 2);
            bf16_t* dst;
            if (br == 0) dst = isq ? QB : (isv ? VB : KB);
            else if (br == 1) dst = isq ? QC : (isv ? VC : KC);
            else dst = (isq ? QD : (isv ? VD : KD)) + (size_t)(br - 2) * Mc * (isq ? 256 : 128);
            const int hs = isq ? 4 : 2, slot = isq ? wc : (wc & 1);
            float frq[8], gn0[8], gn1[8];
            if (br == 0) {
                const float* gp = isq ? bqn : bkn;
#pragma unroll
                for (int e = 0; e < 8; ++e) { frq[e] = fexp2(-(float)(8 * (fq & 1) + e) * (LOG2_THETA / 16.f)) * INV2PI; gn0[e] = gp[8 * fq + e]; gn1[e] = gp[32 + 8 * fq + e]; }
            } else {
#pragma unroll
                for (int e = 0; e < 8; ++e) { frq[e] = fexp2(-(float)(8 * fq + e) * (LOG2_THETA / 32.f)) * INV2PI; gn0[e] = 1.f; gn1[e] = 1.f; }
            }
#pragma unroll
            for (int ai = 0; ai < 2; ++ai)
#pragma unroll
                for (int m = 0; m < 4; ++m) {
                    const int row = rbase + ai * 128 + m * 16, pos = row & 2047;
                    float v0[8], v1[8];
#pragma unroll
                    for (int e = 0; e < 4; ++e) { v0[e] = acc[ai][0][m][0][e]; v0[4 + e] = acc[ai][0][m][1][e]; v1[e] = acc[ai][1][m][0][e]; v1[4 + e] = acc[ai][1][m][1][e]; }
                    if (!isv) {
                        if (br == 0) {
                            float ss = 0.f;
#pragma unroll
                            for (int e = 0; e < 8; ++e) ss += v0[e] * v0[e] + v1[e] * v1[e];
                            ss += shx(ss, 16); ss += shx(ss, 32);
                            const float rstd = __builtin_amdgcn_rsqf(ss * (1.f / 64.f) + EPS);
                            const float P0 = (float)(pos >> 6), P1 = (float)(pos & 63);
#pragma unroll
                            for (int e = 0; e < 8; ++e) {
                                const float a0 = v0[e] * rstd * gn0[e], a1 = v1[e] * rstd * gn1[e];
                                const float b0 = shx(a0, 32), b1 = shx(a1, 32);
                                float c, s;
                                sincos_rev(P0 * frq[e], c, s);
                                v0[e] = (fq < 2) ? (a0 * c - b0 * s) : (b0 * s + a0 * c);
                                sincos_rev(P1 * frq[e], c, s);
                                v1[e] = (fq < 2) ? (a1 * c - b1 * s) : (b1 * s + a1 * c);
                            }
                        } else {
                            const float Pf = (float)pos;
#pragma unroll
                            for (int e = 0; e < 8; ++e) { float c, s; sincos_rev(Pf * frq[e], c, s); const float x1 = v0[e], x2 = v1[e]; v0[e] = x1 * c - x2 * s; v1[e] = x1 * s + x2 * c; }
                        }
                        if (isq) {
#pragma unroll
                            for (int e = 0; e < 8; ++e) { v0[e] *= QS64; v1[e] *= QS64; }
                        }
                    }
                    int drow = row;
                    if (br == 3) drow = (row & ~2047) + ((pos & 3) << 9) + (pos >> 2);
                    else if (br == 4) drow = (row & ~2047) + ((pos & 15) << 7) + (pos >> 4);
                    bf16_t* dp = dst + ((size_t)drow * hs + slot) * 64 + 8 * fq;
                    *(u32x4*)dp = pack8(v0); *(u32x4*)(dp + 32) = pack8(v1);
                }
        } else if (pn == 10) {
#pragma unroll
            for (int ai = 0; ai < 2; ++ai)
#pragma unroll
                for (int m = 0; m < 4; ++m) {
                    const int row = rbase + ai * 128 + m * 16;
                    float ss = 0.f;
#pragma unroll
                    for (int bj = 0; bj < 2; ++bj) {
                        float v[8];
#pragma unroll
                        for (int e = 0; e < 4; ++e) { v[e] = acc[ai][bj][m][0][e]; v[4 + e] = acc[ai][bj][m][1][e]; }
#pragma unroll
                        for (int e = 0; e < 8; ++e) ss += v[e] * v[e];
                        *(u32x4*)(LAT + (size_t)row * 384 + 128 * bj + 32 * wc + 8 * fq) = pack8(v);
                    }
                    ss += shx(ss, 16); ss += shx(ss, 32);
                    if (fq == 0) SSQ[(size_t)row * 8 + wc] = ss;
                }
        } else if (pn == 11) {
            float frq[8];
#pragma unroll
            for (int e = 0; e < 8; ++e) frq[e] = fexp2(-(float)(8 * (fq & 1) + e) * (LOG2_THETA / 16.f)) * INV2PI;
#pragma unroll
            for (int ai = 0; ai < 2; ++ai)
#pragma unroll
                for (int m = 0; m < 4; ++m) {
                    const int row = rbase + ai * 128 + m * 16, pos = row & 2047;
                    float v[8]; float ss = 0.f;
#pragma unroll
                    for (int e = 0; e < 4; ++e) { v[e] = acc[ai][0][m][0][e]; v[4 + e] = acc[ai][0][m][1][e]; }
#pragma unroll
                    for (int e = 0; e < 8; ++e) ss += v[e] * v[e];
                    *(u32x4*)(LAT + (size_t)row * 384 + 256 + 32 * wc + 8 * fq) = pack8(v);
                    ss += shx(ss, 16); ss += shx(ss, 32);
                    if (fq == 0) SSQ[(size_t)row * 8 + 4 + wc] = ss;
                    if (wc == 0) {
                        const float Pf = (float)pos;
#pragma unroll
                        for (int e = 0; e < 4; ++e) { v[e] = acc[ai][1][m][0][e]; v[4 + e] = acc[ai][1][m][1][e]; }
#pragma unroll
                        for (int e = 0; e < 8; ++e) { const float a = v[e], b = shx(a, 32); float c, s; sincos_rev(Pf * frq[e], c, s); v[e] = (fq < 2) ? (a * c - b * s) : (b * s + a * c); }
                        const u32x4 w = pack8(v);
#pragma unroll
                        for (int h = 0; h < 4; ++h) *(u32x4*)(KA + ((size_t)row * 4 + h) * 96 + 64 + 8 * fq) = w;
                    }
                }
        } else {
#pragma unroll
            for (int ai = 0; ai < 2; ++ai)
#pragma unroll
                for (int m = 0; m < 4; ++m) {
                    const int row = rbase + ai * 128 + m * 16;
#pragma unroll
                    for (int bj = 0; bj < 2; ++bj) {
                        float v[8];
#pragma unroll
                        for (int e = 0; e < 4; ++e) { v[e] = acc[ai][bj][m][0][e]; v[4 + e] = acc[ai][bj][m][1][e]; }
#pragma unroll
                        for (int e = 0; e < 8; ++e) v[e] = v[e] * sigmoidf_(v[e]);
                        *(u32x4*)(ZS + (size_t)row * 1024 + 256 * (pn - 12) + 128 * bj + 32 * wc + 8 * fq) = pack8(v);
                    }
                }
        }
    }
};

struct Epi3 {
    bf16_t *QA, *KA, *VA; const float* SSQ;
    DI void operator()(const AccT& acc, const Unit& u, int wv) const {
        EPI_LAUNDER();
        const int rbase = u.pm * 256 + wr * 64 + fr;
        float frq[8];
#pragma unroll
        for (int e = 0; e < 8; ++e) frq[e] = fexp2(-(float)(8 * (fq & 1) + e) * (LOG2_THETA / 16.f)) * INV2PI;
#pragma unroll
        for (int ai = 0; ai < 2; ++ai)
#pragma unroll
            for (int m = 0; m < 4; ++m) {
                const int row = rbase + ai * 128 + m * 16, pos = row & 2047;
                const f32x4 s0 = *(const f32x4*)(SSQ + (size_t)row * 8), s1 = *(const f32x4*)(SSQ + (size_t)row * 8 + 4);
                const float rq = __builtin_amdgcn_rsqf((s0[0] + s0[1] + s0[2] + s0[3]) * (1.f / 256.f) + EPS);
                const float rkv = __builtin_amdgcn_rsqf((s1[0] + s1[1] + s1[2] + s1[3]) * (1.f / 128.f) + EPS);
#pragma unroll
                for (int bj = 0; bj < 2; ++bj) {
                    const int G = 8 * u.pn + 4 * bj + wc;
                    float v[8];
#pragma unroll
                    for (int e = 0; e < 4; ++e) { v[e] = acc[ai][bj][m][0][e]; v[4 + e] = acc[ai][bj][m][1][e]; }
                    if (G < 8) {
                        const float sc = rq * QS96;
#pragma unroll
                        for (int e = 0; e < 8; ++e) v[e] *= sc;
                        *(u32x4*)(QA + ((size_t)row * 4 + (G >> 1)) * 96 + 32 * (G & 1) + 8 * fq) = pack8(v);
                    } else if (G < 12) {
                        const float sc = rq * QS96, Pf = (float)pos;
#pragma unroll
                        for (int e = 0; e < 8; ++e) { const float a = v[e] * sc, b = shx(a, 32); float c, s; sincos_rev(Pf * frq[e], c, s); v[e] = (fq < 2) ? (a * c - b * s) : (b * s + a * c); }
                        *(u32x4*)(QA + ((size_t)row * 4 + (G - 8)) * 96 + 64 + 8 * fq) = pack8(v);
                    } else if (G < 20) {
                        const int Gp = G - 12;
#pragma unroll
                        for (int e = 0; e < 8; ++e) v[e] *= rkv;
                        *(u32x4*)(KA + ((size_t)row * 4 + (Gp >> 1)) * 96 + 32 * (Gp & 1) + 8 * fq) = pack8(v);
                    } else if (G < 28) {
                        const int Gp = G - 20;
#pragma unroll
                        for (int e = 0; e < 8; ++e) v[e] *= rkv;
                        *(u32x4*)(VA + ((size_t)row * 4 + (Gp >> 1)) * 64 + 32 * (Gp & 1) + 8 * fq) = pack8(v);
                    }
                }
            }
    }
};

struct Epi6a {
    bf16_t* P;
    DI void operator()(const AccT& acc, const Unit& u, int wv) const {
        EPI_LAUNDER();
        const int rbase = u.pm * 256 + wr * 64 + fr;
#pragma unroll
        for (int ai = 0; ai < 2; ++ai)
#pragma unroll
            for (int m = 0; m < 4; ++m) {
                const int row = rbase + ai * 128 + m * 16;
#pragma unroll
                for (int bj = 0; bj < 2; ++bj) {
                    float v[8];
#pragma unroll
                    for (int e = 0; e < 4; ++e) { v[e] = acc[ai][bj][m][0][e]; v[4 + e] = acc[ai][bj][m][1][e]; }
                    *(u32x4*)(P + (size_t)row * 4096 + 1024 * u.grp + 256 * u.pn + 128 * bj + 32 * wc + 8 * fq) = pack8(v);
                }
            }
    }
};

struct Epi6b {
    const bf16_t* P; bf16_t* MRG;
    DI void operator()(const AccT& acc, const Unit& u, int wv) const {
        EPI_LAUNDER();
        const int rbase = u.pm * 256 + wr * 64 + fr, c0 = 64 * u.pn + 16 * wc + 4 * fq;
#pragma unroll
        for (int ai = 0; ai < 2; ++ai)
#pragma unroll
            for (int m = 0; m < 4; ++m) {
                const int row = rbase + ai * 128 + m * 16;
                float r[4] = {0.f, 0.f, 0.f, 0.f};
#pragma unroll
                for (int bj = 0; bj < 2; ++bj)
#pragma unroll
                    for (int n = 0; n < 2; ++n) {
                        const u32x2 pw = *(const u32x2*)(P + (size_t)row * 4096 + 1024 * (2 * bj + n) + c0);
                        const f32x4 a = acc[ai][bj][m][n];
                        r[0] += sigmoidf_(a[0]) * bflo(pw.x); r[1] += sigmoidf_(a[1]) * bfhi(pw.x);
                        r[2] += sigmoidf_(a[2]) * bflo(pw.y); r[3] += sigmoidf_(a[3]) * bfhi(pw.y);
                    }
                u32x2 w; w.x = cvtpk(r[0], r[1]); w.y = cvtpk(r[2], r[3]);
                *(u32x2*)(MRG + (size_t)row * 1024 + c0) = w;
            }
    }
};

struct Epi7 {
    const float* xa; const float* xb; size_t split, grow0; float* out;
    DI void operator()(const AccT& acc, const Unit& u, int wv) const {
        EPI_LAUNDER();
        const int rbase = u.pm * 256 + wr * 64 + fr;
#pragma unroll
        for (int ai = 0; ai < 2; ++ai)
#pragma unroll
            for (int m = 0; m < 4; ++m) {
                const int row = rbase + ai * 128 + m * 16;
#pragma unroll
                for (int bj = 0; bj < 2; ++bj) {
                    const int coff = 256 * u.pn + 128 * bj + 32 * wc + 8 * fq;
                    const size_t off = (size_t)row * 1024 + coff;
                    const float* res = row_ptr(xa, xb, split, grow0 + row) + coff;
                    const f32x4 r0 = *(const f32x4*)(res), r1 = *(const f32x4*)(res + 4);
                    *(f32x4*)(out + off) = r0 + acc[ai][bj][m][0];
                    *(f32x4*)(out + off + 4) = r1 + acc[ai][bj][m][1];
                }
            }
    }
};

DI int map_in(int n) {
    const int pn = n >> 8, t = n & 255;
    if (pn < 10) { const int br = pn >> 1, j = pn & 1, s = (t & 127) >> 5, d = 32 * (t >> 7) + (t & 31); return 416 + 512 * br + 256 * j + 64 * s + d; }
    if (pn == 10) return t;
    if (pn == 11) return t < 160 ? 256 + t : -1;
    return 2976 + (n - 3072);
}
DI int map_mg(int n) {
    const int pn = n >> 8, t = n & 255, bj = t >> 7, wc = (t & 127) >> 5, fq = (t & 31) >> 3, nn = (t & 7) >> 2, e = t & 3;
    return 4000 + 1024 * (2 * bj + nn) + 64 * pn + 16 * wc + 4 * fq + e;
}
DI float wsrc(const Params& p, int type, int l, int sub, int n, int k) {
    if (type == 0) { const int s = map_in(n); return s < 0 ? 0.f : p.in[3][((size_t)l * 1024 + k) * NIN + s] * p.in[2][l * 1024 + k]; }
    if (type == 1) { const int s = map_mg(n); return p.in[3][((size_t)l * 1024 + k) * NIN + s] * p.in[2][l * 1024 + k]; }
    if (type == 2) return p.in[11][(((size_t)l * 4 + sub) * 256 + k) * 1024 + n];
    if (type == 3) return p.in[12][((size_t)l * 1024 + k) * 1024 + n];
    const int G = n >> 5, c = n & 31;
    if (G < 12) {
        if (k >= 256) return 0.f;
        const int qc = (G < 8) ? 96 * (G >> 1) + 32 * (G & 1) + c : 96 * (G - 8) + 64 + c;
        return p.in[5][((size_t)l * 256 + k) * 384 + qc] * p.in[4][l * 256 + k];
    }
    if (G < 28) {
        if (k < 256) return 0.f;
        const int Gp = (G < 20) ? G - 12 : G - 20;
        const int kc = 128 * (Gp >> 1) + 32 * (Gp & 1) + c + ((G < 20) ? 0 : 64);
        return p.in[7][((size_t)l * 128 + (k - 256)) * 512 + kc] * p.in[6][l * 128 + (k - 256)];
    }
    return 0.f;
}
#define CTX() unsigned char* ws = launder(p.ws); const int S = launder(p.spc); const int Mc = S * T; const WS w = make_ws((size_t)Mc); (void)ws; (void)w; (void)Mc
DI void phase0(int wv, const Params& p, LAS unsigned char* lds) {
    CTX();
    const int tid = get_tid(wv);
    LAS bf16_t* tile = (LAS bf16_t*)lds;
    constexpr int N0 = 2048, N1 = 2048, N2 = 512, N3 = 512, N4 = 192, NT = N0 + N1 + N2 + N3 + N4;
    for (int it = blockIdx.x; it < NT; it += gridDim.x) {
        int type, l, sub = 0, tn, tk, K; bf16_t* dst;
        if (it < N0) { type = 0; l = it >> 10; const int r = it & 1023; tn = r >> 4; tk = r & 15; K = 1024; dst = (bf16_t*)(ws + w.WinT) + (size_t)l * 4096 * 1024; }
        else if (it < N0 + N1) { const int i2 = it - N0; type = 1; l = i2 >> 10; const int r = i2 & 1023; tn = r >> 4; tk = r & 15; K = 1024; dst = (bf16_t*)(ws + w.WmgT) + (size_t)l * 4096 * 1024; }
        else if (it < N0 + N1 + N2) { const int i2 = it - N0 - N1; type = 2; l = i2 >> 8; sub = (i2 >> 6) & 3; const int r = i2 & 63; tn = r >> 2; tk = r & 3; K = 256; dst = (bf16_t*)(ws + w.WbT) + ((size_t)l * 4 + sub) * 1024 * 256; }
        else if (it < N0 + N1 + N2 + N3) { const int i2 = it - N0 - N1 - N2; type = 3; l = i2 >> 8; const int r = i2 & 255; tn = r >> 4; tk = r & 15; K = 1024; dst = (bf16_t*)(ws + w.WoutT) + (size_t)l * 1024 * 1024; }
        else { const int i2 = it - N0 - N1 - N2 - N3; type = 4; l = i2 / 96; const int r = i2 % 96; tn = r / 6; tk = r % 6; K = 384; dst = (bf16_t*)(ws + w.WupT) + (size_t)l * 1024 * 384; }
        const int n0 = tn * 64, k0 = tk * 64;
#pragma unroll
        for (int j = 0; j < 8; ++j) {
            const int nl = tid & 63, kl = (tid >> 6) + 8 * j;
            const float v = wsrc(p, type, l, sub, n0 + nl, k0 + kl);
            tile[nl * 72 + kl] = (bf16_t)(cvtpk(v, 0.f) & 0xffffu);
        }
        __syncthreads();
        { const int nl = tid >> 3, ks = tid & 7;
          const u32x4 v = *(const LAS u32x4*)(tile + nl * 72 + 8 * ks);
          *(u32x4*)(dst + (size_t)(n0 + nl) * K + k0 + 8 * ks) = v; }
        __syncthreads();
    }
}

DI float wave_sum(float v) { v += shx(v, 1); v += shx(v, 2); v += shx(v, 4); v += shx(v, 8); v += shx(v, 16); v += shx(v, 32); return v; }
DI void phase_prep(int wv, const float* xa, const float* xb, size_t split, size_t grow0, bf16_t* XB, int Mc) {
    const int tidl = get_tid(wv); const int lane = tidl & 63, wave = tidl >> 6;
    for (int row = blockIdx.x * 8 + wave; row < Mc; row += gridDim.x * 8) {
        const f32x4* s = (const f32x4*)row_ptr(xa, xb, split, grow0 + row);
        f32x4 v[4]; float ss = 0.f;
#pragma unroll
        for (int i = 0; i < 4; ++i) { v[i] = s[lane + 64 * i]; ss += v[i][0] * v[i][0] + v[i][1] * v[i][1] + v[i][2] * v[i][2] + v[i][3] * v[i][3]; }
        ss = wave_sum(ss);
        const float rstd = __builtin_amdgcn_rsqf(ss * (1.f / 1024.f) + EPS);
#pragma unroll
        for (int i = 0; i < 4; ++i) { u32x2 w; w.x = cvtpk(v[i][0] * rstd, v[i][1] * rstd); w.y = cvtpk(v[i][2] * rstd, v[i][3] * rstd); *(u32x2*)(XB + (size_t)row * 1024 + 4 * (lane + 64 * i)) = w; }
    }
}
DI void phase_final(int wv, float* io  , const float* g, int Mc) {
    const int tidl = get_tid(wv); const int lane = tidl & 63, wave = tidl >> 6;
    for (int row = blockIdx.x * 8 + wave; row < Mc; row += gridDim.x * 8) {
        f32x4* s = (f32x4*)(io + (size_t)row * 1024);
        f32x4 v[4]; float ss = 0.f;
#pragma unroll
        for (int i = 0; i < 4; ++i) { v[i] = s[lane + 64 * i]; ss += v[i][0] * v[i][0] + v[i][1] * v[i][1] + v[i][2] * v[i][2] + v[i][3] * v[i][3]; }
        ss = wave_sum(ss);
        const float rstd = 1.0f / sqrtf(ss * (1.f / 1024.f) + EPS);
#pragma unroll
        for (int i = 0; i < 4; ++i) { const f32x4 gg = ((const f32x4*)g)[lane + 64 * i]; s[lane + 64 * i] = v[i] * rstd * gg; }
    }
}

#define GAS __attribute__((address_space(1)))
DI u32x4 gld16(const void* p) { return *(const GAS u32x4*)(unsigned long long)p; }
DI float max3f(float a, float b, float c) { float r; asm("v_max3_f32 %0, %1, %2, %3" : "=v"(r) : "v"(a), "v"(b), "v"(c)); return r; }
DI int crow(int r, int h) { return (r & 3) + 8 * (r >> 2) + 4 * h; }
DI s16x4 vtr(const LAS unsigned char* p) { return __builtin_bit_cast(s16x4, __builtin_amdgcn_ds_read_tr16_b64_v4i16((LAS s16x4*)p)); }
DI bf16x8 packp(const f32x16& x, int s) {
    u32x4 w; w.x = cvtpk(x[8 * s], x[8 * s + 1]); w.y = cvtpk(x[8 * s + 2], x[8 * s + 3]); w.z = cvtpk(x[8 * s + 4], x[8 * s + 5]); w.w = cvtpk(x[8 * s + 6], x[8 * s + 7]);
    return __builtin_bit_cast(bf16x8, w);
}

struct ADesc { int type;
               const bf16_t *Q, *K, *V; int qs, ks, vs, kt0, kt1, qpos0, window;
               bf16_t* dst; const bf16_t* gate; float* lse; int qh; };
struct ACtx { unsigned char* ws; int S, wave; };
DI ADesc attn_decode(int it, const ACtx& cx) {
    unsigned char* ws = launder(cx.ws); const int S = launder(cx.S), wave = cx.wave; const size_t Mc = (size_t)S * T; const WS w = make_ws(Mc);
    const int nA = S * 32, nB = S * 32, nC = S * 32, ntot = S * 192;
    ADesc d; d.type = 0; d.Q = d.K = d.V = nullptr; d.qs = d.ks = d.vs = 0; d.kt0 = d.kt1 = 0; d.qpos0 = 0; d.window = 0; d.dst = nullptr; d.gate = nullptr; d.lse = nullptr; d.qh = 0;
    if (it >= ntot) return d;
    bf16_t* YG = (bf16_t*)(ws + w.YG); const bf16_t* ZS = (const bf16_t*)(ws + w.ZS);
    if (it < nA) {
        const int b = it >> 5, rem = it & 31, head = rem >> 3, qt = rem & 7;
        const int t0 = 256 * qt + 32 * wave; const size_t row0 = (size_t)b * T, rw0 = row0 + t0;
        d.type = 1;
        d.Q = (const bf16_t*)(ws + w.QA) + (rw0 * 4 + head) * 96; d.qs = 384;
        d.K = (const bf16_t*)(ws + w.KA) + (row0 * 4 + head) * 96; d.ks = 384;
        d.V = (const bf16_t*)(ws + w.VA) + (row0 * 4 + head) * 64; d.vs = 256;
        d.kt0 = 0; d.kt1 = 32;
        d.dst = YG + rw0 * 256 + head * 64; d.gate = ZS + rw0 * 1024 + head * 64; d.qh = head;
    } else if (it < nA + nB + nC) {
        const bool isC = it >= nA + nB;
        const int i2 = it - nA - (isC ? nB : 0);
        const int b = i2 >> 5, rem = i2 & 31, kvh = rem >> 4, qt = rem & 15;
        const int qh = 2 * kvh + (wave >> 2), t0 = 128 * qt + 32 * (wave & 3); const size_t row0 = (size_t)b * T, rw0 = row0 + t0;
        d.type = isC ? 3 : 2;
        d.Q = (const bf16_t*)(ws + (isC ? w.QC : w.QB)) + (rw0 * 4 + qh) * 64; d.qs = 256;
        d.K = (const bf16_t*)(ws + (isC ? w.KC : w.KB)) + (row0 * 2 + kvh) * 64; d.ks = 128;
        d.V = (const bf16_t*)(ws + (isC ? w.VC : w.VB)) + (row0 * 2 + kvh) * 64; d.vs = 128;
        d.qh = qh;
        if (!isC) { d.kt0 = 0; d.kt1 = 32; d.dst = YG + (Mc + rw0) * 256 + qh * 64; d.gate = ZS + rw0 * 1024 + 256 + qh * 64; }
        else { int k0 = 2 * qt - 2, k1 = 2 * qt + 4; if (k0 < 0) k0 = 0; if (k1 > 32) k1 = 32;
               d.kt0 = k0; d.kt1 = k1; d.qpos0 = t0; d.window = 128; d.dst = YG + (2 * Mc + rw0) * 256 + qh * 64; d.gate = ZS + rw0 * 1024 + 512 + qh * 64; }
    } else {
        const int i2 = it - nA - nB - nC;
        const int b = i2 / 96, rem = i2 % 96, g = rem >> 5, rem2 = rem & 31, kvh = rem2 >> 4, qt = rem2 & 15;
        const int Ls = 2048 >> (2 * g);
        const int tp0 = 128 * qt, sb = tp0 & ~(Ls - 1), u0 = tp0 - sb;
        const int qh = 2 * kvh + (wave >> 2), wq = 32 * (wave & 3); const size_t row0 = (size_t)b * T, rw0 = row0 + tp0 + wq;
        d.type = 4;
        d.Q = (const bf16_t*)(ws + w.QD) + (size_t)g * Mc * 256 + (rw0 * 4 + qh) * 64; d.qs = 256;
        d.K = (const bf16_t*)(ws + w.KD) + (size_t)g * Mc * 128 + ((row0 + sb) * 2 + kvh) * 64; d.ks = 128;
        d.V = (const bf16_t*)(ws + w.VD) + (size_t)g * Mc * 128 + ((row0 + sb) * 2 + kvh) * 64; d.vs = 128;
        int k0 = (u0 >> 6) - 1, k1 = (u0 >> 6) + 3; if (k0 < 0) k0 = 0; if (k1 > (Ls >> 6)) k1 = (Ls >> 6);
        d.kt0 = k0; d.kt1 = k1; d.qpos0 = u0 + wq; d.window = 64; d.qh = qh;
        d.dst = (bf16_t*)(ws + w.OD) + (size_t)g * Mc * 256 + rw0 * 256 + qh * 64;
        d.lse = (float*)(ws + w.LSE) + (size_t)g * Mc * 4 + rw0 * 4 + qh;
    }
    return d;
}

struct AttnPre { bf16x8 q[6]; u32x4 a0, a1, av; };

template <int DQK>
DI void attn_issue(AttnPre& P, int tid, const ADesc& d) {
    constexpr int NDS = DQK / 16, CPR = DQK / 8;
    const int lane = tid & 63, r32 = lane & 31, h = lane >> 5;
    const bf16_t* qp = d.Q + (size_t)r32 * d.qs + 8 * h;
#pragma unroll
    for (int ds = 0; ds < NDS; ++ds) P.q[ds] = __builtin_bit_cast(bf16x8, gld16(qp + 16 * ds));
    const int kr0 = tid / CPR, kc0 = tid % CPR, kr1 = (tid + 512) / CPR, kc1 = (tid + 512) % CPR;
    const bool k2 = (DQK == 96) && (tid < 256);
    const int vr = tid >> 3, vc = tid & 7;
    const bf16_t* kg0 = d.K + (size_t)kr0 * d.ks + kc0 * 8;
    const bf16_t* kg1 = d.K + (size_t)kr1 * d.ks + kc1 * 8;
    const bf16_t* vg = d.V + (size_t)vr * d.vs + vc * 8;
    { const size_t ko = (size_t)d.kt0 * 64 * d.ks, vo = (size_t)d.kt0 * 64 * d.vs;
      P.a0 = gld16(kg0 + ko); if (k2) P.a1 = gld16(kg1 + ko); P.av = gld16(vg + vo); }
}

template <int DQK, bool WIN>
DI void attn_run(int wv, const ACtx& cx, int it, int itn, const AttnPre& P, AttnPre& Pn, LAS unsigned char* lds, f32x16 (&o)[2], float& m_out, float& l_out) {
    const ADesc dsc = attn_decode(it, cx);
    const bf16_t* Kb = dsc.K; const bf16_t* Vb = dsc.V; const int ks = dsc.ks, vs = dsc.vs, kt0 = dsc.kt0, kt1 = dsc.kt1, qpos0 = dsc.qpos0, window = dsc.window;
    constexpr int KP = DQK * 2 + 16, VP = 144, KBYTES = 64 * KP, VBYTES = 64 * VP, BUF = KBYTES + VBYTES, NDS = DQK / 16, CPR = DQK / 8;
    const int tid = get_tid(wv), lane = tid & 63, r32 = lane & 31, h = lane >> 5;
    bf16x8 q[NDS];
#pragma unroll
    for (int ds = 0; ds < NDS; ++ds) q[ds] = P.q[ds];
    const int kr0 = tid / CPR, kc0 = tid % CPR;
    const int kr1 = (tid + 512) / CPR, kc1 = (tid + 512) % CPR;
    const bool k2 = (DQK == 96) && (tid < 256);
    const int vr = tid >> 3, vc = tid & 7;
    const bf16_t* kg0 = Kb + (size_t)kr0 * ks + kc0 * 8;
    const bf16_t* kg1 = Kb + (size_t)kr1 * ks + kc1 * 8;
    const bf16_t* vg = Vb + (size_t)vr * vs + vc * 8;
    const int kl0 = kr0 * KP + kc0 * 16, kl1 = kr1 * KP + kc1 * 16, vl = KBYTES + vr * VP + vc * 16;
    const int kfo = r32 * KP + h * 16;
    const int i16 = lane & 15, qq = i16 >> 2, pp = i16 & 3, blk = (lane >> 4) & 1;
    const int vfo = KBYTES + (4 * h + qq) * VP + 32 * blk + 8 * pp;
#pragma unroll
    for (int i = 0; i < 16; ++i) { o[0][i] = 0.f; o[1][i] = 0.f; }
    float mrun = 0.f, lrun = 0.f; bool first = true;
    f32x16 negm;
#pragma unroll
    for (int i = 0; i < 16; ++i) negm[i] = 0.f;
#define ATTN_BAR() asm volatile("s_waitcnt lgkmcnt(0)\n\ts_barrier" ::: "memory")
    u32x4 rk0, rk1 = (u32x4){0u, 0u, 0u, 0u}, rv;
    u32x4 nk0, nk1 = (u32x4){0u, 0u, 0u, 0u}, nv;
    *(LAS u32x4*)(lds + kl0) = P.a0; if (k2) *(LAS u32x4*)(lds + kl1) = P.a1; *(LAS u32x4*)(lds + vl) = P.av;
    rk0 = P.a0; rv = P.av;
    if (kt0 + 1 < kt1) { const size_t ko = (size_t)(kt0 + 1) * 64 * ks, vo = (size_t)(kt0 + 1) * 64 * vs;
      rk0 = gld16(kg0 + ko); if (k2) rk1 = gld16(kg1 + ko); rv = gld16(vg + vo); }
    nk0 = rk0; nv = rv;
    ATTN_BAR();
    for (int kt = kt0; kt < kt1; ++kt) {
        const int buf = (kt - kt0) & 1;
        const bool more = (kt + 1 < kt1);
        if (kt == kt1 - 1) { const ADesc nd = attn_decode(itn, cx); if (nd.type == 1) attn_issue<96>(Pn, tid, nd); else if (nd.type >= 2) attn_issue<64>(Pn, tid, nd); }
        if (kt + 2 < kt1) { const size_t ko = (size_t)(kt + 2) * 64 * ks, vo = (size_t)(kt + 2) * 64 * vs;
            nk0 = gld16(kg0 + ko); if (k2) nk1 = gld16(kg1 + ko); nv = gld16(vg + vo); }
        bool need = true;
        if (WIN) need = (64 * kt + 63 >= qpos0 - window) && (64 * kt <= qpos0 + 31 + window);
        if (need) {
            const LAS unsigned char* base = lds + buf * BUF;
            bf16x8 kf0[NDS], kf1[NDS];
#pragma unroll
            for (int ds = 0; ds < NDS; ++ds) {
                kf0[ds] = *(const LAS bf16x8*)(base + kfo + ds * 32);
                kf1[ds] = *(const LAS bf16x8*)(base + kfo + 32 * KP + ds * 32);
            }
            f32x16 p0 = __builtin_amdgcn_mfma_f32_32x32x16_bf16(kf0[0], q[0], negm, 0, 0, 0);
            f32x16 p1 = __builtin_amdgcn_mfma_f32_32x32x16_bf16(kf1[0], q[0], negm, 0, 0, 0);
#pragma unroll
            for (int ds = 1; ds < NDS; ++ds) {
                p0 = __builtin_amdgcn_mfma_f32_32x32x16_bf16(kf0[ds], q[ds], p0, 0, 0, 0);
                p1 = __builtin_amdgcn_mfma_f32_32x32x16_bf16(kf1[ds], q[ds], p1, 0, 0, 0);
            }
            s16x4 vlo[4][2], vhi[4][2];
#pragma unroll
            for (int k4 = 0; k4 < 4; ++k4)
#pragma unroll
                for (int db = 0; db < 2; ++db) {
                    vlo[k4][db] = vtr(base + vfo + (16 * k4) * VP + 64 * db);
                    vhi[k4][db] = vtr(base + vfo + (16 * k4 + 8) * VP + 64 * db);
                }
            if (WIN) {
                const int qp_ = qpos0 + r32, kb_ = 64 * kt + 4 * h;
#pragma unroll
                for (int r = 0; r < 16; ++r) {
                    const int kk = kb_ + (r & 3) + 8 * (r >> 2);
                    int d0 = qp_ - kk; d0 = d0 < 0 ? -d0 : d0;
                    int d1 = qp_ - kk - 32; d1 = d1 < 0 ? -d1 : d1;
                    if (d0 > window) p0[r] = -1e30f;
                    if (d1 > window) p1[r] = -1e30f;
                }
            }
            float mxa = max3f(p0[0], p0[1], p1[0]), mxb = max3f(p0[2], p0[3], p1[1]);
            mxa = max3f(mxa, p1[2], p1[3]);
#pragma unroll
            for (int r = 4; r < 16; r += 4) { mxa = max3f(mxa, p0[r], p0[r + 1]); mxb = max3f(mxb, p0[r + 2], p0[r + 3]); mxa = max3f(mxa, p1[r], p1[r + 1]); mxb = max3f(mxb, p1[r + 2], p1[r + 3]); }
            float mx = max3f(mxa, mxb, mxb);
            mx = max3f(mx, shx(mx, 32), mx);
            if (first || __any(mx > 8.0f)) {
                const float d = first ? (WIN ? fmaxf(mx, -1e20f) : mx) : fmaxf(mx, 0.f);
                const float alpha = first ? 1.f : fexp2(-d);
                mrun += d;
                first = false;
#pragma unroll
                for (int i = 0; i < 16; ++i) { negm[i] = -mrun; p0[i] -= d; p1[i] -= d; o[0][i] *= alpha; o[1][i] *= alpha; }
                lrun *= alpha;
            }
            float ls = 0.f;
#pragma unroll
            for (int r = 0; r < 16; ++r) { p0[r] = fexp2(p0[r]); p1[r] = fexp2(p1[r]); ls += p0[r] + p1[r]; }
            lrun += ls;
#pragma unroll
            for (int k4 = 0; k4 < 4; ++k4) {
                const bf16x8 pf = packp((k4 < 2) ? p0 : p1, k4 & 1);
#pragma unroll
                for (int db = 0; db < 2; ++db) {
                    const bf16x8 vf = __builtin_shufflevector(vlo[k4][db], vhi[k4][db], 0, 1, 2, 3, 4, 5, 6, 7);
                    o[db] = __builtin_amdgcn_mfma_f32_32x32x16_bf16(vf, pf, o[db], 0, 0, 0);
                }
            }
        }
        if (more) { LAS unsigned char* nb = lds + (buf ^ 1) * BUF;
            *(LAS u32x4*)(nb + kl0) = rk0; if (k2) *(LAS u32x4*)(nb + kl1) = rk1; *(LAS u32x4*)(nb + vl) = rv; }
        ATTN_BAR();
        rk0 = nk0; rk1 = nk1; rv = nv;
    }
    m_out = mrun; l_out = lrun + shx(lrun, 32);
}

constexpr int ATTN_STAGE_OFF = 49152, ATTN_STAGE_WAVE = 32 * 144;
DI void attn_store(const f32x16 (&o)[2], float inv, bf16_t* d0, int dstride, const bf16_t* g0, int gstride, int lane, LAS unsigned char* stage) {
    const int r32 = lane & 31, h = lane >> 5;
#pragma unroll
    for (int db = 0; db < 2; ++db)
#pragma unroll
        for (int g = 0; g < 4; ++g) {
            const int d = 32 * db + 8 * g + 4 * h;
            u32x2 w; w.x = cvtpk(o[db][4 * g] * inv, o[db][4 * g + 1] * inv); w.y = cvtpk(o[db][4 * g + 2] * inv, o[db][4 * g + 3] * inv);
            *(LAS u32x2*)(stage + r32 * 144 + d * 2) = w;
        }
    asm volatile("s_waitcnt lgkmcnt(0)" ::: "memory");
    const int row = lane >> 1, half = lane & 1;
    u32x4 v[4];
#pragma unroll
    for (int i = 0; i < 4; ++i) v[i] = *(const LAS u32x4*)(stage + row * 144 + half * 64 + 16 * i);
    if (g0) {
        const bf16_t* gp = g0 + (size_t)row * gstride + half * 32;
#pragma unroll
        for (int i = 0; i < 4; ++i) {
            const u32x4 z = gld16(gp + 8 * i);
#pragma unroll
            for (int k = 0; k < 4; ++k) v[i][k] = cvtpk(bflo(v[i][k]) * bflo(z[k]), bfhi(v[i][k]) * bfhi(z[k]));
        }
    }
    bf16_t* dp = d0 + (size_t)row * dstride + half * 32;
#pragma unroll
    for (int i = 0; i < 4; ++i) *(u32x4*)(dp + 8 * i) = v[i];
    asm volatile("s_waitcnt lgkmcnt(0)" ::: "memory");
}

DI void phase_attn(int wv, const Params& p, int layer, LAS unsigned char* lds) {
    const int tidl = get_tid(wv); const int wave = __builtin_amdgcn_readfirstlane(tidl >> 6), lane = tidl & 63, r32 = lane & 31, h = lane >> 5;
    ACtx cx; cx.ws = launder(p.ws); cx.S = launder(p.spc); cx.wave = wave;
    const int ntot = cx.S * 192;
    LAS unsigned char* stage = lds + ATTN_STAGE_OFF + wave * ATTN_STAGE_WAVE;
    const int Gb = gridDim.x, vcu = (Gb % 8 == 0) ? ((int)blockIdx.x % 8) * (Gb / 8) + (int)blockIdx.x / 8 : (int)blockIdx.x;
    AttnPre P;
    { const ADesc d0 = attn_decode(vcu, cx); if (d0.type == 1) attn_issue<96>(P, tidl, d0); else if (d0.type >= 2) attn_issue<64>(P, tidl, d0); }
    for (int it = vcu; it < ntot; it += Gb) {
        const int ty = attn_decode(it, cx).type;
        AttnPre Pn = P;
        f32x16 o[2]; float mr, lr;
        if (ty == 1) attn_run<96, false>(wv, cx, it, it + Gb, P, Pn, lds, o, mr, lr);
        else if (ty == 2) attn_run<64, false>(wv, cx, it, it + Gb, P, Pn, lds, o, mr, lr);
        else attn_run<64, true>(wv, cx, it, it + Gb, P, Pn, lds, o, mr, lr);
        const ADesc e = attn_decode(it, cx);
        float lt = lr;
        if (ty == 3) lt += fexp2(p.in[10][layer * 4 + e.qh] * LOG2E - mr);
        attn_store(o, __builtin_amdgcn_rcpf(lt), e.dst, 256, e.gate, 1024, lane, stage);
        if (ty == 4 && h == 0) e.lse[(size_t)r32 * 4] = mr + __builtin_amdgcn_logf(lr);
        P = Pn;
    }
}

DI void phase_dcombine(int wv, const Params& p) {
    unsigned char* ws = launder(p.ws); const int S = launder(p.spc); const size_t Mc = (size_t)S * T; const WS w = make_ws(Mc);
    const bf16_t* OD = (const bf16_t*)(ws + w.OD); const float* LSE = (const float*)(ws + w.LSE);
    const bf16_t* ZS = (const bf16_t*)(ws + w.ZS); bf16_t* YG = (bf16_t*)(ws + w.YG) + 3 * Mc * 256;
    const size_t total = Mc * 32;
    for (size_t idx = (size_t)blockIdx.x * 512 + get_tid(wv); idx < total; idx += (size_t)gridDim.x * 512) {
        const size_t row = idx >> 5; const int hd = (int)(idx & 31), head = hd >> 3, c8 = hd & 7;
        const int pos = (int)(row & 2047); const size_t rb = row - pos;
        const size_t r1 = rb + ((pos & 3) << 9) + (pos >> 2), r2 = rb + ((pos & 15) << 7) + (pos >> 4);
        const float l0 = LSE[row * 4 + head], l1 = LSE[Mc * 4 + r1 * 4 + head], l2 = LSE[2 * Mc * 4 + r2 * 4 + head];
        const float mx = fmaxf(l0, fmaxf(l1, l2));
        float w0 = fexp2(l0 - mx), w1 = fexp2(l1 - mx), w2 = fexp2(l2 - mx);
        const float inv = __builtin_amdgcn_rcpf(w0 + w1 + w2); w0 *= inv; w1 *= inv; w2 *= inv;
        const u32x4 a = *(const u32x4*)(OD + row * 256 + head * 64 + c8 * 8);
        const u32x4 b = *(const u32x4*)(OD + Mc * 256 + r1 * 256 + head * 64 + c8 * 8);
        const u32x4 c = *(const u32x4*)(OD + 2 * Mc * 256 + r2 * 256 + head * 64 + c8 * 8);
        const u32x4 z = *(const u32x4*)(ZS + row * 1024 + 768 + head * 64 + c8 * 8);
        u32x4 r;
#pragma unroll
        for (int i = 0; i < 4; ++i) {
            const float lo = (w0 * bflo(a[i]) + w1 * bflo(b[i]) + w2 * bflo(c[i])) * bflo(z[i]);
            const float hi = (w0 * bfhi(a[i]) + w1 * bfhi(b[i]) + w2 * bfhi(c[i])) * bfhi(z[i]);
            r[i] = cvtpk(lo, hi);
        }
        *(u32x4*)(YG + row * 256 + head * 64 + c8 * 8) = r;
    }
}


#define XB_TMO      128
#define XB_XCNT(j)  (256  + 64 * (j))
#define XB_XSUB(j)  (1280 + 64 * (j))
#define XB_XGEN(j)  (2304 + 64 * (j))
#define XB_TOP      3328
#define XB_TOPGEN   3392
#define XCD_BAR_WORDS 3456
#define XB_SPIN_CAP (1u << 20)
DI unsigned xb_ld(unsigned* p) { return __hip_atomic_load(p, __ATOMIC_RELAXED, __HIP_MEMORY_SCOPE_AGENT); }
DI unsigned xb_add(unsigned* p, unsigned v) { return __hip_atomic_fetch_add(p, v, __ATOMIC_RELAXED, __HIP_MEMORY_SCOPE_AGENT); }
DI unsigned xb_xcc_id() { return (unsigned)__builtin_amdgcn_s_getreg((3 << 11) | 20) & 0xFu; }
#define XB_SPIN(cond, bar) do { unsigned _sp = 0; while (cond) { __builtin_amdgcn_s_sleep(1); \
    if ((++_sp & 255u) == 0u) { if (xb_ld(&(bar)[XB_TMO])) break; if (_sp > XB_SPIN_CAP) { atomicAdd(&(bar)[XB_TMO], 1u); break; } } } } while (0)
DI void xcd_barrier_complete(unsigned* bar, unsigned x, unsigned& nloc, unsigned& nx) {
    const unsigned G = gridDim.x;
    unsigned sum, cnt, mine, sp = 0u;
    for (;;) {
        sum = 0u; cnt = 0u; mine = 0u;
#pragma unroll
        for (unsigned j = 0; j < 16; ++j) { const unsigned c = xb_ld(&bar[XB_XCNT(j)]); sum += c; cnt += (c > 0u) ? 1u : 0u; mine = (j == x) ? c : mine; }
        if (sum == G) break;
        __builtin_amdgcn_s_sleep(1);
        if ((++sp & 255u) == 0u) { if (xb_ld(&bar[XB_TMO])) break; if (sp > XB_SPIN_CAP) { atomicAdd(&bar[XB_TMO], 1u); break; } }
    }
    nloc = mine > 0u ? mine : 1u; nx = cnt > 0u ? cnt : 1u;
}
DI void xcd_barrier(int wv, unsigned* bar0, volatile LAS unsigned* st) {
    asm volatile("s_waitcnt vmcnt(0)" ::: "memory");
    __syncthreads();
    if (get_tid(wv) == 0) {
        unsigned* bar = launder(bar0);
        const unsigned x = xb_xcc_id();
        __builtin_amdgcn_s_waitcnt(0);
        unsigned nloc = st[0], nx = st[1];
        if (nloc == 0u) { xcd_barrier_complete(bar, x, nloc, nx); st[0] = nloc; st[1] = nx; }
        const unsigned old = xb_add(&bar[XB_XSUB(x)], 1u);
        const unsigned gen = old / nloc;
        if (old + 1u == (gen + 1u) * nloc) {
            __builtin_amdgcn_fence(__ATOMIC_RELEASE, "agent");
            asm volatile("s_waitcnt vmcnt(0)" ::: "memory");
            const unsigned og = xb_add(&bar[XB_TOP], 1u);
            const unsigned tg = og / nx;
            if (og + 1u == (tg + 1u) * nx) xb_add(&bar[XB_TOPGEN], 1u);
            else XB_SPIN(xb_ld(&bar[XB_TOPGEN]) == tg, bar);
            __builtin_amdgcn_fence(__ATOMIC_ACQUIRE, "agent");
            xb_add(&bar[XB_XGEN(x)], 1u);
            asm volatile("s_waitcnt vmcnt(0)" ::: "memory");
        } else {
            XB_SPIN(xb_ld(&bar[XB_XGEN(x)]) == gen, bar);
            __builtin_amdgcn_fence(__ATOMIC_ACQUIRE, "agent");
            asm volatile("s_waitcnt vmcnt(0)" ::: "memory");
        }
    }
    __syncthreads();
}

__global__ void __launch_bounds__(512) mega_fwd(Params p) {
    extern __shared__ __attribute__((aligned(16))) unsigned char lds_raw[];
    LAS unsigned char* lds = (LAS unsigned char*)lds_raw;
    cg::grid_group grid = cg::this_grid();
    const int G = gridDim.x, c = blockIdx.x;
    const int wv = __builtin_amdgcn_readfirstlane((int)threadIdx.x >> 6);
    volatile LAS unsigned* bst = (volatile LAS unsigned*)(lds + 131072);
    unsigned* bar0;
    { const WS w0 = make_ws((size_t)p.spc * T); bar0 = (unsigned*)(p.ws + w0.END);
      if (threadIdx.x == 0) { bst[0] = 0u; bst[1] = 0u; (void)xb_add(&bar0[XB_XCNT(xb_xcc_id())], 1u); } }
    __syncthreads();
#define GSYNC() xcd_barrier(wv, bar0, bst)

#ifndef STOPAT
#define STOPAT 99
#endif
    phase0(wv, p, lds);
    grid.sync();
    if (STOPAT == 0) return;

    for (int ch = 0; ch < p.nchunk; ++ch) {
        for (int l = 0; l < 2; ++l) {
#define ROWS() const size_t grow0 = (size_t)ch * Mc; float* outb = launder(p.out); float* outc = outb + grow0 * 1024; \
            const float* xa = launder((l == 0) ? p.in[0] : (const float*)outb); const float* xb2 = launder(p.in[1]); const size_t split = (l == 0) ? (size_t)PROMPT_ROWS : ~(size_t)0; (void)outc
            { CTX(); ROWS(); phase_prep(wv, xa, xb2, split, grow0, (bf16_t*)(ws + w.XB), Mc); }
            GSYNC();
            if (STOPAT == 1) return;
            { CTX();
              pg8::Gemm g{(const bf16_t*)(ws + w.XB), (const bf16_t*)(ws + w.WinT) + (size_t)l * 4096 * 1024, 1024, 0, 0};
              pg8::Order O; O.init(Mc, 4096, 1, G, c);
              Epi1 E{ws, p.in[8] + l * 64, p.in[9] + l * 64, (size_t)Mc};
              pg8::gemm_phase(wv, lds, g, O, E); }
            GSYNC();
            if (STOPAT == 2) return;
            { CTX();
              pg8::Gemm g{(const bf16_t*)(ws + w.LAT), (const bf16_t*)(ws + w.WupT) + (size_t)l * 1024 * 384, 384, 0, 0};
              pg8::Order O; O.init(Mc, 1024, 1, G, c);
              Epi3 E{(bf16_t*)(ws + w.QA), (bf16_t*)(ws + w.KA), (bf16_t*)(ws + w.VA), (const float*)(ws + w.SSQ)};
              pg8::gemm_phase(wv, lds, g, O, E); }
            GSYNC();
            if (STOPAT == 3) return;
            phase_attn(wv, p, l, lds);
            GSYNC();
            if (STOPAT == 4) return;
            phase_dcombine(wv, p);
            GSYNC();
            if (STOPAT == 5) return;
#define RUN_P6A(SUB) { CTX(); const int Ms = Mc / NSUB; const size_t r0s = (size_t)(SUB) * Ms; \
                  pg8::Gemm g{(const bf16_t*)(ws + w.YG) + r0s * 256, (const bf16_t*)(ws + w.WbT) + (size_t)l * 4 * 1024 * 256, 256, (size_t)Mc * 512, (size_t)1024 * 256 * 2}; \
                  pg8::Order O; O.init(Ms, 1024, 4, G, c); \
                  Epi6a E{(bf16_t*)(ws + w.P) + (size_t)((SUB) & 1) * Ms * 4096}; \
                  pg8::gemm_phase(wv, lds, g, O, E); }
            RUN_P6A(0);
            GSYNC();
            for (int sub = 0; sub < NSUB; ++sub) {
                { CTX(); const int Ms = Mc / NSUB; const size_t r0s = (size_t)sub * Ms;
                  pg8::Gemm g{(const bf16_t*)(ws + w.XB) + r0s * 1024, (const bf16_t*)(ws + w.WmgT) + (size_t)l * 4096 * 1024, 1024, 0, 0};
                  pg8::Order O; O.init(Ms, 4096, 1, G, c);
                  Epi6b E{(const bf16_t*)(ws + w.P) + (size_t)(sub & 1) * Ms * 4096, (bf16_t*)(ws + w.MRG) + r0s * 1024};
                  pg8::gemm_phase(wv, lds, g, O, E); }
                if (sub + 1 < NSUB) RUN_P6A(sub + 1);
                GSYNC();
            }
            { CTX(); ROWS();
              pg8::Gemm g{(const bf16_t*)(ws + w.MRG), (const bf16_t*)(ws + w.WoutT) + (size_t)l * 1024 * 1024, 1024, 0, 0};
              pg8::Order O; O.init(Mc, 1024, 1, G, c);
              Epi7 E{xa, xb2, split, grow0, outc};
              pg8::gemm_phase(wv, lds, g, O, E); }
            GSYNC();
            if (STOPAT == 8) return;
        }
        { CTX(); const int l = 1; ROWS(); phase_final(wv, outc, p.in[13], Mc); }
    }
}

extern "C" void kernel_launch(void* const* d_in, const int* in_sizes, int n_in, void* d_out, int out_size, void* d_ws, size_t ws_size, hipStream_t stream) {
    constexpr int LDS_BYTES = 131072 + 256;
    static int grid_blocks = 0;
    if (!grid_blocks) {
        int dev = 0, cus = 0, per_cu = 0;
        hipGetDevice(&dev);
        hipDeviceGetAttribute(&cus, hipDeviceAttributeMultiprocessorCount, dev);
        hipFuncSetAttribute((const void*)mega_fwd, hipFuncAttributeMaxDynamicSharedMemorySize, LDS_BYTES);
        hipOccupancyMaxActiveBlocksPerMultiprocessor(&per_cu, (const void*)mega_fwd, 512, LDS_BYTES);
        if (per_cu < 1) per_cu = 1;
        grid_blocks = cus * per_cu;
    }
    Params p{};
    for (int i = 0; i < 14; ++i) p.in[i] = (const float*)d_in[i];
    p.out = (float*)d_out; p.ws = (unsigned char*)d_ws;
    int spc = 24;
    while (spc > 1 && make_ws((size_t)spc * T).END + XCD_BAR_WORDS * 4 > ws_size) { spc = (spc == 24) ? 16 : spc / 2; }
    p.spc = spc; p.nchunk = NSEQ / spc;
    (void)hipMemsetAsync((unsigned char*)d_ws + make_ws((size_t)spc * T).END, 0, XCD_BAR_WORDS * 4, stream);
    void* args[] = {&p};
    hipError_t e = hipLaunchCooperativeKernel((const void*)mega_fwd, dim3(grid_blocks), dim3(512), args, LDS_BYTES, stream);
    if (e != hipSuccess) fprintf(stderr, "cooperative launch failed: %s (grid %d)\n", hipGetErrorString(e), grid_blocks);
}
```

```cpp
#include <hip/hip_runtime.h>
#include <hip/hip_cooperative_groups.h>
#include <cstdio>
namespace cg = cooperative_groups;

#define LAS __attribute__((address_space(3)))
#define DI __device__ __forceinline__
typedef unsigned short bf16_t;
typedef short bf16x8 __attribute__((ext_vector_type(8)));
typedef short s16x4 __attribute__((ext_vector_type(4)));
typedef float f32x4 __attribute__((ext_vector_type(4)));
typedef float f32x16 __attribute__((ext_vector_type(16)));
typedef unsigned u32x4 __attribute__((ext_vector_type(4)));
typedef unsigned u32x2 __attribute__((ext_vector_type(2)));
typedef float f32x2_t __attribute__((ext_vector_type(2)));
typedef __bf16 bf16x2_t __attribute__((ext_vector_type(2)));

DI unsigned cvtpk(float lo, float hi) { f32x2_t v = {lo, hi}; bf16x2_t b = __builtin_convertvector(v, bf16x2_t); return __builtin_bit_cast(unsigned, b); }
DI float bflo(unsigned w) { return __uint_as_float(w << 16); }
DI float bfhi(unsigned w) { return __uint_as_float(w & 0xffff0000u); }
DI float fexp2(float x) { return __builtin_amdgcn_exp2f(x); }
DI float sigmoidf_(float x) { return __builtin_amdgcn_rcpf(1.f + fexp2(-1.4426950408889634f * x)); }
DI u32x4 pack8(const float* v) { u32x4 w; w.x = cvtpk(v[0], v[1]); w.y = cvtpk(v[2], v[3]); w.z = cvtpk(v[4], v[5]); w.w = cvtpk(v[6], v[7]); return w; }

template <class Tp> DI Tp* launder(Tp* p) { unsigned long long v = (unsigned long long)p; asm volatile("" : "+s"(v)); return (Tp*)v; }
DI int launder(int v) { asm volatile("" : "+s"(v)); return v; }
DI int vlaunder(int v) { asm volatile("" : "+v"(v)); return v; }
DI int get_tid(int wv) { return launder(wv) * 64 + (int)__builtin_amdgcn_mbcnt_hi(~0u, __builtin_amdgcn_mbcnt_lo(~0u, (unsigned)vlaunder(0))); }
constexpr int NSUB = 4;
constexpr int T = 2048, DM = 1024, NSEQ = 48, NIN = 8096, PROMPT_ROWS = 32 * 2048;
constexpr float EPS = 1e-6f, LOG2E = 1.4426950408889634f;
constexpr float QS64 = 0.125f * LOG2E;
constexpr float QS96 = 0.10206207261596575f * LOG2E;
constexpr float INV2PI = 0.15915494309189535f;
constexpr float LOG2_THETA = 13.287712379549449f;

struct Params { const float* in[14]; float* out; unsigned char* ws; int spc; int nchunk; };

struct WS { size_t WinT, WmgT, WbT, WoutT, WupT, SSQ, XB, QB, KB, VB, QC, KC, VC, QD, KD, VD, LAT, ZS, QA, KA, VA, OD, LSE, P, YG, MRG, END; };
__host__ __device__ inline size_t al256(size_t x) { return (x + 255) & ~(size_t)255; }
__host__ __device__ inline WS make_ws(size_t Mc) {
    WS w; size_t o = 0;
    w.WinT = o; o += (size_t)2 * 4096 * 1024 * 2;
    w.WmgT = o; o += (size_t)2 * 4096 * 1024 * 2;
    w.WbT = o; o += (size_t)2 * 4 * 1024 * 256 * 2;
    w.WoutT = o; o += (size_t)2 * 1024 * 1024 * 2;
    w.WupT = o; o += (size_t)2 * 1024 * 384 * 2;
    w.SSQ = o; o += al256(Mc * 8 * 4);
    w.XB = o; o += Mc * 2048;
    size_t r0 = o;
    w.QB = o; o += Mc * 512; w.KB = o; o += Mc * 256; w.VB = o; o += Mc * 256;
    w.QC = o; o += Mc * 512; w.KC = o; o += Mc * 256; w.VC = o; o += Mc * 256;
    w.QD = o; o += Mc * 1536; w.KD = o; o += Mc * 768; w.VD = o; o += Mc * 768;
    w.LAT = o; o += Mc * 768; w.ZS = o; o += Mc * 2048;
    w.QA = o; o += Mc * 768; w.KA = o; o += Mc * 768; w.VA = o; o += Mc * 512;
    w.OD = o; o += Mc * 1536; w.LSE = o; o += Mc * 48;
    w.P = r0;
    if (o < r0 + Mc * 8192) o = r0 + Mc * 8192;
    o = al256(o);
    w.YG = o; o += Mc * 2048;
    w.MRG = o; o += Mc * 2048;
    w.END = o; return w;
}

namespace pg8 {
constexpr int BM = 256, BK = 64, HALF = 128, HTB = HALF * BK * 2, NXCD = 8, WGM = 8;
DI int lds_byte(int r, int c) { const int st = (r >> 4) * 2 + (c >> 5), rr = r & 15, cc = c & 31, ob = rr * 64 + cc * 2; return st * 1024 + (ob ^ (((ob >> 9) & 1) << 5)); }
DI void stage_rc(int b, int& R, int& C) { const int st = b / 1024, sb = b % 1024, swz = sb ^ (((sb >> 9) & 1) << 5); R = (st >> 1) * 16 + swz / 64; C = (st & 1) * 32 + (swz % 64) / 2; }
DI int perm32(int rho) { const int n = rho >> 4, i = rho & 15; return 8 * (i >> 2) + 4 * n + (i & 3); }

struct Unit { int pm, pn, grp; };
struct Gemm { const bf16_t* A; const bf16_t* Bt; int K; size_t gsA, gsB; };
struct Order {
    int lgN, nwg, ntot, G, c;
    DI void init(int M, int N, int ngrp_, int G_, int c_) { const int nM = M / BM, nN = N / BM; lgN = (nN == 16) ? 4 : 2; nwg = nM * nN; ntot = nwg * ngrp_; G = G_; c = c_; }
    DI bool next(int i, Unit& u) const {
        const int L = i * G + c; if (L >= ntot) return false;
        const int grp = (L >= nwg) + (L >= 2 * nwg) + (L >= 3 * nwg);
        int wgid = L - grp * nwg;
        wgid = (wgid & 7) * (nwg >> 3) + (wgid >> 3);
        const int gid = wgid >> (3 + lgN), rem = wgid & ((8 << lgN) - 1);
        u.pm = gid * 8 + (rem & 7); u.pn = rem >> 3; u.grp = grp; return true;
    }
};

template <class Epi>
DI void gemm_phase(int wv, LAS unsigned char* lds, const Gemm g, const Order& S, const Epi& E) {
    const int tid = get_tid(wv), wid = __builtin_amdgcn_readfirstlane(tid >> 6), lane = tid & 63, wr = wid >> 2, wc = wid & 3, fr = lane & 15, fq = lane >> 4;
    const int K = g.K, nt = K / BK;
    unsigned voffA[2], voffB[2];
#pragma unroll
    for (int i = 0; i < 2; ++i) { int R, C; stage_rc(tid * 16 + i * 8192, R, C); const int Rb = (R & ~31) + perm32(R & 31);
        voffA[i] = (unsigned)(R * K + C) * 2u; voffB[i] = (unsigned)(Rb * K + C) * 2u; }
    const size_t kstep = (size_t)(BK * 2);
    const size_t hstep = (size_t)HALF * K * 2;
    const size_t tstep = 2 * hstep;
    const unsigned ldsw = (unsigned)wid * 1024u;
    const int aoff = lds_byte(wr * 64 + fr, fq * 8), boff = lds_byte(wc * 32 + fr, fq * 8);
#define PG8_SA(b, h) (((b) * 2 + (h)) * HTB)
#define PG8_SB(b, h) ((4 + (b) * 2 + (h)) * HTB)
#define PG8_STAGE(bufoff, gbase, voff) do { _Pragma("unroll") for (int _i = 0; _i < 2; ++_i) \
        __builtin_amdgcn_global_load_lds((const unsigned*)((const char*)(gbase) + (voff)[_i]), (LAS unsigned*)(lds + (bufoff) + ldsw + _i * 8192), 16, 0, 0); } while (0)
#define PG8_LDA(dst, b, h) do { _Pragma("unroll") for (int m = 0; m < 4; ++m) _Pragma("unroll") for (int k = 0; k < 2; ++k) dst[m][k] = *(const LAS bf16x8*)(lds + PG8_SA(b, h) + aoff + m * 2048 + k * 1024); } while (0)
#define PG8_LDB(dst, b, h) do { _Pragma("unroll") for (int n = 0; n < 2; ++n) _Pragma("unroll") for (int k = 0; k < 2; ++k) dst[n][k] = *(const LAS bf16x8*)(lds + PG8_SB(b, h) + boff + n * 2048 + k * 1024); } while (0)
#define PG8_MMA(ai, bj, At, Bt) do { __builtin_amdgcn_s_setprio(1); _Pragma("unroll") for (int m = 0; m < 4; ++m) _Pragma("unroll") for (int n = 0; n < 2; ++n) _Pragma("unroll") for (int k = 0; k < 2; ++k) \
        acc[ai][bj][m][n] = __builtin_amdgcn_mfma_f32_16x16x32_bf16(Bt[n][k], At[m][k], acc[ai][bj][m][n], 0, 0, 0); __builtin_amdgcn_s_setprio(0); } while (0)
#define PG8_WAIT_V(n) asm volatile("s_waitcnt vmcnt(" #n ")" ::: "memory")
#define PG8_WAIT_L(n) asm volatile("s_waitcnt lgkmcnt(" #n ")" ::: "memory")
#define PG8_BAR __builtin_amdgcn_s_barrier()
#define PG8_SCHED __builtin_amdgcn_sched_barrier(0)
    Unit cur, nxt; int ui = 0;
    if (!S.next(0, cur)) return;
    f32x4 acc[2][2][4][2];
#pragma unroll
    for (int a = 0; a < 2; ++a)
#pragma unroll
        for (int b = 0; b < 2; ++b)
#pragma unroll
            for (int m = 0; m < 4; ++m)
#pragma unroll
                for (int n = 0; n < 2; ++n) acc[a][b][m][n] = (f32x4){0.f, 0.f, 0.f, 0.f};
    bf16x8 At[4][2], B0[2][2], B1[2][2];
    const char* cA = (const char*)g.A + (size_t)cur.grp * g.gsA + (size_t)cur.pm * tstep; const char* cB = (const char*)g.Bt + (size_t)cur.grp * g.gsB + (size_t)cur.pn * tstep;
    PG8_STAGE(PG8_SB(0, 0), cB, voffB); PG8_STAGE(PG8_SB(0, 1), cB + hstep, voffB); PG8_STAGE(PG8_SA(0, 0), cA, voffA); PG8_STAGE(PG8_SA(0, 1), cA + hstep, voffA);
    if (wr == 1) PG8_BAR;
    PG8_WAIT_V(2); PG8_BAR;
    PG8_STAGE(PG8_SB(1, 0), cB + kstep, voffB); PG8_STAGE(PG8_SA(1, 0), cA + kstep, voffA); PG8_STAGE(PG8_SB(1, 1), cB + hstep + kstep, voffB);
    PG8_WAIT_V(6); PG8_BAR;
    for (;;) {
        const bool has_next = S.next(ui + 1, nxt);
        const char* nA = has_next ? (const char*)g.A + (size_t)nxt.grp * g.gsA + (size_t)nxt.pm * tstep : cA;
        const char* nB = has_next ? (const char*)g.Bt + (size_t)nxt.grp * g.gsB + (size_t)nxt.pn * tstep : cB;
        for (int t = 0; t < nt; t += 2) {
            const bool last = (t == nt - 2);
            const char* a1 = cA + (size_t)(t + 1) * kstep;
            const char* a2 = last ? nA : cA + (size_t)(t + 2) * kstep; const char* b2 = last ? nB : cB + (size_t)(t + 2) * kstep;
            const char* a3 = a2 + kstep; const char* b3 = b2 + kstep;
            PG8_LDB(B0, 0, 0); PG8_LDB(B1, 0, 1); PG8_SCHED; PG8_LDA(At, 0, 0); PG8_STAGE(PG8_SA(1, 1), a1 + hstep, voffA);
            PG8_WAIT_V(8); PG8_WAIT_L(0); PG8_BAR; PG8_MMA(0, 0, At, B0); PG8_MMA(0, 1, At, B1); PG8_BAR; PG8_SCHED;
            PG8_LDA(At, 0, 1); PG8_STAGE(PG8_SB(0, 0), b2, voffB); PG8_STAGE(PG8_SB(0, 1), b2 + hstep, voffB); PG8_STAGE(PG8_SA(0, 0), a2, voffA);
            PG8_WAIT_V(8); PG8_WAIT_L(0); PG8_BAR; PG8_MMA(1, 0, At, B0); PG8_MMA(1, 1, At, B1); PG8_BAR; PG8_SCHED;
            PG8_LDB(B0, 1, 0); PG8_LDB(B1, 1, 1); PG8_SCHED; PG8_LDA(At, 1, 0); PG8_STAGE(PG8_SA(0, 1), a2 + hstep, voffA);
            PG8_WAIT_V(8); PG8_WAIT_L(0); PG8_BAR; PG8_MMA(0, 0, At, B0); PG8_MMA(0, 1, At, B1); PG8_BAR; PG8_SCHED;
            PG8_LDA(At, 1, 1); PG8_STAGE(PG8_SB(1, 0), b3, voffB); PG8_STAGE(PG8_SB(1, 1), b3 + hstep, voffB); PG8_STAGE(PG8_SA(1, 0), a3, voffA);
            PG8_WAIT_V(8); PG8_WAIT_L(0); PG8_BAR; PG8_MMA(1, 0, At, B0); PG8_MMA(1, 1, At, B1); PG8_BAR; PG8_SCHED;
        }
        if (wr == 0) PG8_BAR;
        E(acc, cur, wv);
        if (!has_next) break;
#pragma unroll
        for (int a = 0; a < 2; ++a)
#pragma unroll
            for (int b = 0; b < 2; ++b)
#pragma unroll
                for (int m = 0; m < 4; ++m)
#pragma unroll
                    for (int n = 0; n < 2; ++n) acc[a][b][m][n] = (f32x4){0.f, 0.f, 0.f, 0.f};
        cur = nxt; cA = nA; cB = nB; ++ui;
        if (wr == 1) PG8_BAR;
    }
    PG8_WAIT_V(0);
    PG8_BAR;
#undef PG8_SA
#undef PG8_SB
#undef PG8_STAGE
#undef PG8_LDA
#undef PG8_LDB
#undef PG8_MMA
#undef PG8_WAIT_V
#undef PG8_WAIT_L
#undef PG8_BAR
#undef PG8_SCHED
}
}
using pg8::Unit;
typedef f32x4 AccT[2][2][4][2];

DI void sincos_rev(float rev, float& c, float& s) { const float f = __builtin_amdgcn_fractf(rev); c = __builtin_amdgcn_cosf(f); s = __builtin_amdgcn_sinf(f); }
DI float shx(float v, int m) { return __shfl_xor(v, m, 64); }
#define EPI_LAUNDER() const int wid_ = launder(wv), wr = wid_ >> 2, wc = wid_ & 3; const int lane_ = (int)__builtin_amdgcn_mbcnt_hi(~0u, __builtin_amdgcn_mbcnt_lo(~0u, (unsigned)vlaunder(0))); const int fr = lane_ & 15, fq = lane_ >> 4

DI const float* row_ptr(const float* xa, const float* xb, size_t split, size_t R) { return (R < split) ? xa + R * 1024 : xb + (R - split) * 1024; }
struct Epi1 {
    unsigned char* ws0; const float *bqn, *bkn; size_t Mc;
    DI void operator()(const AccT& acc, const Unit& u, int wv) const {
        EPI_LAUNDER();
        unsigned char* ws = launder(ws0); const WS w = make_ws(Mc);
        bf16_t *QB = (bf16_t*)(ws + w.QB), *KB = (bf16_t*)(ws + w.KB), *VB = (bf16_t*)(ws + w.VB), *QC = (bf16_t*)(ws + w.QC), *KC = (bf16_t*)(ws + w.KC), *VC = (bf16_t*)(ws + w.VC);
        bf16_t *QD = (bf16_t*)(ws + w.QD), *KD = (bf16_t*)(ws + w.KD), *VD = (bf16_t*)(ws + w.VD), *LAT = (bf16_t*)(ws + w.LAT), *ZS = (bf16_t*)(ws + w.ZS), *KA = (bf16_t*)(ws + w.KA);
        float* SSQ = (float*)(ws + w.SSQ);
        const int pn = u.pn, rbase = u.pm * 256 + wr * 64 + fr;
        if (pn < 10) {
            const int br = pn >> 1, j = pn & 1;
            const bool isq = !j, isv = j && (wc >= 2);
            bf16_t* dst;
            if (br == 0) dst = isq ? QB : (isv ? VB : KB);
            else if (br == 1) dst = isq ? QC : (isv ? VC : KC);
            else dst = (isq ? QD : (isv ? VD : KD)) + (size_t)(br - 2) * Mc * (isq ? 256 : 128);
            const int hs = isq ? 4 : 2, slot = isq ? wc : (wc & 1);
            float frq[8], gn0[8], gn1[8];
            if (br == 0) {
                const float* gp = isq ? bqn : bkn;
#pragma unroll
                for (int e = 0; e < 8; ++e) { frq[e] = fexp2(-(float)(8 * (fq & 1) + e) * (LOG2_THETA / 16.f)) * INV2PI; gn0[e] = gp[8 * fq + e]; gn1[e] = gp[32 + 8 * fq + e]; }
            } else {
#pragma unroll
                for (int e = 0; e < 8; ++e) { frq[e] = fexp2(-(float)(8 * fq + e) * (LOG2_THETA / 32.f)) * INV2PI; gn0[e] = 1.f; gn1[e] = 1.f; }
            }
#pragma unroll
            for (int ai = 0; ai < 2; ++ai)
#pragma unroll
                for (int m = 0; m < 4; ++m) {
                    const int row = rbase + ai * 128 + m * 16, pos = row & 2047;
                    float v0[8], v1[8];
#pragma unroll
                    for (int e = 0; e < 4; ++e) { v0[e] = acc[ai][0][m][0][e]; v0[4 + e] = acc[ai][0][m][1][e]; v1[e] = acc[ai][1][m][0][e]; v1[4 + e] = acc[ai][1][m][1][e]; }
                    if (!isv) {
                        if (br == 0) {
                            float ss = 0.f;
#pragma unroll
                            for (int e = 0; e < 8; ++e) ss += v0[e] * v0[e] + v1[e] * v1[e];
                            ss += shx(ss, 16); ss += shx(ss, 32);
                            const float rstd = __builtin_amdgcn_rsqf(ss * (1.f / 64.f) + EPS);
                            const float P0 = (float)(pos >> 6), P1 = (float)(pos & 63);
#pragma unroll
                            for (int e = 0; e < 8; ++e) {
                                const float a0 = v0[e] * rstd * gn0[e], a1 = v1[e] * rstd * gn1[e];
                                const float b0 = shx(a0, 32), b1 = shx(a1, 32);
                                float c, s;
                                sincos_rev(P0 * frq[e], c, s);
                                v0[e] = (fq < 2) ? (a0 * c - b0 * s) : (b0 * s + a0 * c);
                                sincos_rev(P1 * frq[e], c, s);
                                v1[e] = (fq < 2) ? (a1 * c - b1 * s) : (b1 * s + a1 * c);
                            }
                        } else {
                            const float Pf = (float)pos;
#pragma unroll
                            for (int e = 0; e < 8; ++e) { float c, s; sincos_rev(Pf * frq[e], c, s); const float x1 = v0[e], x2 = v1[e]; v0[e] = x1 * c - x2 * s; v1[e] = x1 * s + x2 * c; }
                        }
                        if (isq) {
#pragma unroll
                            for (int e = 0; e < 8; ++e) { v0[e] *= QS64; v1[e] *= QS64; }
                        }
                    }
                    int drow = row;
                    if (br == 3) drow = (row & ~2047) + ((pos & 3) << 9) + (pos >> 2);
                    else if (br == 4) drow = (row & ~2047) + ((pos & 15) << 7) + (pos >> 4);
                    bf16_t* dp = dst + ((size_t)drow * hs + slot) * 64 + 8 * fq;
                    *(u32x4*)dp = pack8(v0); *(u32x4*)(dp + 32) = pack8(v1);
                }
        } else if (pn == 10) {
#pragma unroll
            for (int ai = 0; ai < 2; ++ai)
#pragma unroll
                for (int m = 0; m < 4; ++m) {
                    const int row = rbase + ai * 128 + m * 16;
                    float ss = 0.f;
#pragma unroll
                    for (int bj = 0; bj < 2; ++bj) {
                        float v[8];
#pragma unroll
                        for (int e = 0; e < 4; ++e) { v[e] = acc[ai][bj][m][0][e]; v[4 + e] = acc[ai][bj][m][1][e]; }
#pragma unroll
                        for (int e = 0; e < 8; ++e) ss += v[e] * v[e];
                        *(u32x4*)(LAT + (size_t)row * 384 + 128 * bj + 32 * wc + 8 * fq) = pack8(v);
                    }
                    ss += shx(ss, 16); ss += shx(ss, 32);
                    if (fq == 0) SSQ[(size_t)row * 8 + wc] = ss;
                }
        } else if (pn == 11) {
            float frq[8];
#pragma unroll
            for (int e = 0; e < 8; ++e) frq[e] = fexp2(-(float)(8 * (fq & 1) + e) * (LOG2_THETA / 16.f)) * INV2PI;
#pragma unroll
            for (int ai = 0; ai < 2; ++ai)
#pragma unroll
                for (int m = 0; m < 4; ++m) {
                    const int row = rbase + ai * 128 + m * 16, pos = row & 2047;
                    float v[8]; float ss = 0.f;
#pragma unroll
                    for (int e = 0; e < 4; ++e) { v[e] = acc[ai][0][m][0][e]; v[4 + e] = acc[ai][0][m][1][e]; }
#pragma unroll
                    for (int e = 0; e < 8; ++e) ss += v[e] * v[e];
                    *(u32x4*)(LAT + (size_t)row * 384 + 256 + 32 * wc + 8 * fq) = pack8(v);
                    ss += shx(ss, 16); ss += shx(ss, 32);
                    if (fq == 0) SSQ[(size_t)row * 8 + 4 + wc] = ss;
                    if (wc == 0) {
                        const float Pf = (float)pos;
#pragma unroll
                        for (int e = 0; e < 4; ++e) { v[e] = acc[ai][1][m][0][e]; v[4 + e] = acc[ai][1][m][1][e]; }
#pragma unroll
                        for (int e = 0; e < 8; ++e) { const float a = v[e], b = shx(a, 32); float c, s; sincos_rev(Pf * frq[e], c, s); v[e] = (fq < 2) ? (a * c - b * s) : (b * s + a * c); }
                        const u32x4 w = pack8(v);
#pragma unroll
                        for (int h = 0; h < 4; ++h) *(u32x4*)(KA + ((size_t)row * 4 + h) * 96 + 64 + 8 * fq) = w;
                    }
                }
        } else {
#pragma unroll
            for (int ai = 0; ai < 2; ++ai)
#pragma unroll
                for (int m = 0; m < 4; ++m) {
                    const int row = rbase + ai * 128 + m * 16;
#pragma unroll
                    for (int bj = 0; bj < 2; ++bj) {
                        float v[8];
#pragma unroll
                        for (int e = 0; e < 4; ++e) { v[e] = acc[ai][bj][m][0][e]; v[4 + e] = acc[ai][bj][m][1][e]; }
#pragma unroll
                        for (int e = 0; e < 8; ++e) v[e] = v[e] * sigmoidf_(v[e]);
                        *(u32x4*)(ZS + (size_t)row * 1024 + 256 * (pn - 12) + 128 * bj + 32 * wc + 8 * fq) = pack8(v);
                    }
                }
        }
    }
};

struct Epi3 {
    bf16_t *QA, *KA, *VA; const float* SSQ;
    DI void operator()(const AccT& acc, const Unit& u, int wv) const {
        EPI_LAUNDER();
        const int rbase = u.pm * 256 + wr * 64 + fr;
        float frq[8];
#pragma unroll
        for (int e = 0; e < 8; ++e) frq[e] = fexp2(-(float)(8 * (fq & 1) + e) * (LOG2_THETA / 16.f)) * INV2PI;
#pragma unroll
        for (int ai = 0; ai < 2; ++ai)
#pragma unroll
            for (int m = 0; m < 4; ++m) {
                const int row = rbase + ai * 128 + m * 16, pos = row & 2047;
                const f32x4 s0 = *(const f32x4*)(SSQ + (size_t)row * 8), s1 = *(const f32x4*)(SSQ + (size_t)row * 8 + 4);
                const float rq = __builtin_amdgcn_rsqf((s0[0] + s0[1] + s0[2] + s0[3]) * (1.f / 256.f) + EPS);
                const float rkv = __builtin_amdgcn_rsqf((s1[0] + s1[1] + s1[2] + s1[3]) * (1.f / 128.f) + EPS);
#pragma unroll
                for (int bj = 0; bj < 2; ++bj) {
                    const int G = 8 * u.pn + 4 * bj + wc;
                    float v[8];
#pragma unroll
                    for (int e = 0; e < 4; ++e) { v[e] = acc[ai][bj][m][0][e]; v[4 + e] = acc[ai][bj][m][1][e]; }
                    if (G < 8) {
                        const float sc = rq * QS96;
#pragma unroll
                        for (int e = 0; e < 8; ++e) v[e] *= sc;
                        *(u32x4*)(QA + ((size_t)row * 4 + (G >> 1)) * 96 + 32 * (G & 1) + 8 * fq) = pack8(v);
                    } else if (G < 12) {
                        const float sc = rq * QS96, Pf = (float)pos;
#pragma unroll
                        for (int e = 0; e < 8; ++e) { const float a = v[e] * sc, b = shx(a, 32); float c, s; sincos_rev(Pf * frq[e], c, s); v[e] = (fq < 2) ? (a * c - b * s) : (b * s + a * c); }
                        *(u32x4*)(QA + ((size_t)row * 4 + (G - 8)) * 96 + 64 + 8 * fq) = pack8(v);
                    } else if (G < 20) {
                        const int Gp = G - 12;
#pragma unroll
                        for (int e = 0; e < 8; ++e) v[e] *= rkv;
                        *(u32x4*)(KA + ((size_t)row * 4 + (Gp >> 1)) * 96 + 32 * (Gp & 1) + 8 * fq) = pack8(v);
                    } else if (G < 28) {
                        const int Gp = G - 20;
#pragma unroll
                        for (int e = 0; e < 8; ++e) v[e] *= rkv;
                        *(u32x4*)(VA + ((size_t)row * 4 + (Gp >> 1)) * 64 + 32 * (Gp & 1) + 8 * fq) = pack8(v);
                    }
                }
            }
    }
};

struct Epi6a {
    bf16_t* P;
    DI void operator()(const AccT& acc, const Unit& u, int wv) const {
        EPI_LAUNDER();
        const int rbase = u.pm * 256 + wr * 64 + fr;
#pragma unroll
        for (int ai = 0; ai < 2; ++ai)
#pragma unroll
            for (int m = 0; m < 4; ++m) {
                const int row = rbase + ai * 128 + m * 16;
#pragma unroll
                for (int bj = 0; bj < 2; ++bj) {
                    float v[8];
#pragma unroll
                    for (int e = 0; e < 4; ++e) { v[e] = acc[ai][bj][m][0][e]; v[4 + e] = acc[ai][bj][m][1][e]; }
                    *(u32x4*)(P + (size_t)row * 4096 + 1024 * u.grp + 256 * u.pn + 128 * bj + 32 * wc + 8 * fq) = pack8(v);
                }
            }
    }
};

struct Epi6b {
    const bf16_t* P; bf16_t* MRG;
    DI void operator()(const AccT& acc, const Unit& u, int wv) const {
        EPI_LAUNDER();
        const int rbase = u.pm * 256 + wr * 64 + fr, c0 = 64 * u.pn + 16 * wc + 4 * fq;
#pragma unroll
        for (int ai = 0; ai < 2; ++ai)
#pragma unroll
            for (int m = 0; m < 4; ++m) {
                const int row = rbase + ai * 128 + m * 16;
                float r[4] = {0.f, 0.f, 0.f, 0.f};
#pragma unroll
                for (int bj = 0; bj < 2; ++bj)
#pragma unroll
                    for (int n = 0; n < 2; ++n) {
                        const u32x2 pw = *(const u32x2*)(P + (size_t)row * 4096 + 1024 * (2 * bj + n) + c0);
                        const f32x4 a = acc[ai][bj][m][n];
                        r[0] += sigmoidf_(a[0]) * bflo(pw.x); r[1] += sigmoidf_(a[1]) * bfhi(pw.x);
                        r[2] += sigmoidf_(a[2]) * bflo(pw.y); r[3] += sigmoidf_(a[3]) * bfhi(pw.y);
                    }
                u32x2 w; w.x = cvtpk(r[0], r[1]); w.y = cvtpk(r[2], r[3]);
                *(u32x2*)(MRG + (size_t)row * 1024 + c0) = w;
            }
    }
};

struct Epi7 {
    const float* xa; const float* xb; size_t split, grow0; float* out;
    DI void operator()(const AccT& acc, const Unit& u, int wv) const {
        EPI_LAUNDER();
        const int rbase = u.pm * 256 + wr * 64 + fr;
#pragma unroll
        for (int ai = 0; ai < 2; ++ai)
#pragma unroll
            for (int m = 0; m < 4; ++m) {
                const int row = rbase + ai * 128 + m * 16;
#pragma unroll
                for (int bj = 0; bj < 2; ++bj) {
                    const int coff = 256 * u.pn + 128 * bj + 32 * wc + 8 * fq;
                    const size_t off = (size_t)row * 1024 + coff;
                    const float* res = row_ptr(xa, xb, split, grow0 + row) + coff;
                    const f32x4 r0 = *(const f32x4*)(res), r1 = *(const f32x4*)(res + 4);
                    *(f32x4*)(out + off) = r0 + acc[ai][bj][m][0];
                    *(f32x4*)(out + off + 4) = r1 + acc[ai][bj][m][1];
                }
            }
    }
};

DI int map_in(int n) {
    const int pn = n >> 8, t = n & 255;
    if (pn < 10) { const int br = pn >> 1, j = pn & 1, s = (t & 127) >> 5, d = 32 * (t >> 7) + (t & 31); return 416 + 512 * br + 256 * j + 64 * s + d; }
    if (pn == 10) return t;
    if (pn == 11) return t < 160 ? 256 + t : -1;
    return 2976 + (n - 3072);
}
DI int map_mg(int n) {
    const int pn = n >> 8, t = n & 255, bj = t >> 7, wc = (t & 127) >> 5, fq = (t & 31) >> 3, nn = (t & 7) >> 2, e = t & 3;
    return 4000 + 1024 * (2 * bj + nn) + 64 * pn + 16 * wc + 4 * fq + e;
}
DI float wsrc(const Params& p, int type, int l, int sub, int n, int k) {
    if (type == 0) { const int s = map_in(n); return s < 0 ? 0.f : p.in[3][((size_t)l * 1024 + k) * NIN + s] * p.in[2][l * 1024 + k]; }
    if (type == 1) { const int s = map_mg(n); return p.in[3][((size_t)l * 1024 + k) * NIN + s] * p.in[2][l * 1024 + k]; }
    if (type == 2) return p.in[11][(((size_t)l * 4 + sub) * 256 + k) * 1024 + n];
    if (type == 3) return p.in[12][((size_t)l * 1024 + k) * 1024 + n];
    const int G = n >> 5, c = n & 31;
    if (G < 12) {
        if (k >= 256) return 0.f;
        const int qc = (G < 8) ? 96 * (G >> 1) + 32 * (G & 1) + c : 96 * (G - 8) + 64 + c;
        return p.in[5][((size_t)l * 256 + k) * 384 + qc] * p.in[4][l * 256 + k];
    }
    if (G < 28) {
        if (k < 256) return 0.f;
        const int Gp = (G < 20) ? G - 12 : G - 20;
        const int kc = 128 * (Gp >> 1) + 32 * (Gp & 1) + c + ((G < 20) ? 0 : 64);
        return p.in[7][((size_t)l * 128 + (k - 256)) * 512 + kc] * p.in[6][l * 128 + (k - 256)];
    }
    return 0.f;
}
#define CTX() unsigned char* ws = launder(p.ws); const int S = launder(p.spc); const int Mc = S * T; const WS w = make_ws((size_t)Mc); (void)ws; (void)w; (void)Mc
DI void phase0(int wv, const Params& p, LAS unsigned char* lds) {
    CTX();
    const int tid = get_tid(wv);
    LAS bf16_t* tile = (LAS bf16_t*)lds;
    constexpr int N0 = 2048, N1 = 2048, N2 = 512, N3 = 512, N4 = 192, NT = N0 + N1 + N2 + N3 + N4;
    for (int it = blockIdx.x; it < NT; it += gridDim.x) {
        int type, l, sub = 0, tn, tk, K; bf16_t* dst;
        if (it < N0) { type = 0; l = it >> 10; const int r = it & 1023; tn = r >> 4; tk = r & 15; K = 1024; dst = (bf16_t*)(ws + w.WinT) + (size_t)l * 4096 * 1024; }
        else if (it < N0 + N1) { const int i2 = it - N0; type = 1; l = i2 >> 10; const int r = i2 & 1023; tn = r >> 4; tk = r & 15; K = 1024; dst = (bf16_t*)(ws + w.WmgT) + (size_t)l * 4096 * 1024; }
        else if (it < N0 + N1 + N2) { const int i2 = it - N0 - N1; type = 2; l = i2 >> 8; sub = (i2 >> 6) & 3; const int r = i2 & 63; tn = r >> 2; tk = r & 3; K = 256; dst = (bf16_t*)(ws + w.WbT) + ((size_t)l * 4 + sub) * 1024 * 256; }
        else if (it < N0 + N1 + N2 + N3) { const int i2 = it - N0 - N1 - N2; type = 3; l = i2 >> 8; const int r = i2 & 255; tn = r >> 4; tk = r & 15; K = 1024; dst = (bf16_t*)(ws + w.WoutT) + (size_t)l * 1024 * 1024; }
        else { const int i2 = it - N0 - N1 - N2 - N3; type = 4; l = i2 / 96; const int r = i2 % 96; tn = r / 6; tk = r % 6; K = 384; dst = (bf16_t*)(ws + w.WupT) + (size_t)l * 1024 * 384; }
        const int n0 = tn * 64, k0 = tk * 64;
#pragma unroll
        for (int j = 0; j < 8; ++j) {
            const int nl = tid & 63, kl = (tid >> 6) + 8 * j;
            const float v = wsrc(p, type, l, sub, n0 + nl, k0 + kl);
            tile[nl * 72 + kl] = (bf16_t)(cvtpk(v, 0.f) & 0xffffu);
        }
        __syncthreads();
        { const int nl = tid >> 3, ks = tid & 7;
          const u32x4 v = *(const LAS u32x4*)(tile + nl * 72 + 8 * ks);
          *(u32x4*)(dst + (size_t)(n0 + nl) * K + k0 + 8 * ks) = v; }
        __syncthreads();
    }
}

DI float wave_sum(float v) { v += shx(v, 1); v += shx(v, 2); v += shx(v, 4); v += shx(v, 8); v += shx(v, 16); v += shx(v, 32); return v; }
DI void phase_prep(int wv, const float* xa, const float* xb, size_t split, size_t grow0, bf16_t* XB, int Mc) {
    const int tidl = get_tid(wv); const int lane = tidl & 63, wave = tidl >> 6;
    for (int row = blockIdx.x * 8 + wave; row < Mc; row += gridDim.x * 8) {
        const f32x4* s = (const f32x4*)row_ptr(xa, xb, split, grow0 + row);
        f32x4 v[4]; float ss = 0.f;
#pragma unroll
        for (int i = 0; i < 4; ++i) { v[i] = s[lane + 64 * i]; ss += v[i][0] * v[i][0] + v[i][1] * v[i][1] + v[i][2] * v[i][2] + v[i][3] * v[i][3]; }
        ss = wave_sum(ss);
        const float rstd = __builtin_amdgcn_rsqf(ss * (1.f / 1024.f) + EPS);
#pragma unroll
        for (int i = 0; i < 4; ++i) { u32x2 w; w.x = cvtpk(v[i][0] * rstd, v[i][1] * rstd); w.y = cvtpk(v[i][2] * rstd, v[i][3] * rstd); *(u32x2*)(XB + (size_t)row * 1024 + 4 * (lane + 64 * i)) = w; }
    }
}
DI void phase_final(int wv, float* io  , const float* g, int Mc) {
    const int tidl = get_tid(wv); const int lane = tidl & 63, wave = tidl >> 6;
    for (int row = blockIdx.x * 8 + wave; row < Mc; row += gridDim.x * 8) {
        f32x4* s = (f32x4*)(io + (size_t)row * 1024);
        f32x4 v[4]; float ss = 0.f;
#pragma unroll
        for (int i = 0; i < 4; ++i) { v[i] = s[lane + 64 * i]; ss += v[i][0] * v[i][0] + v[i][1] * v[i][1] + v[i][2] * v[i][2] + v[i][3] * v[i][3]; }
        ss = wave_sum(ss);
        const float rstd = 1.0f / sqrtf(ss * (1.f / 1024.f) + EPS);
#pragma unroll
        for (int i = 0; i < 4; ++i) { const f32x4 gg = ((const f32x4*)g)[lane + 64 * i]; s[lane + 64 * i] = v[i] * rstd * gg; }
    }
}

#define GAS __attribute__((address_space(1)))
DI u32x4 gld16(const void* p) { return *(const GAS u32x4*)(unsigned long long)p; }
DI float max3f(float a, float b, float c) { float r; asm("v_max3_f32 %0, %1, %2, %3" : "=v"(r) : "v"(a), "v"(b), "v"(c)); return r; }
DI int crow(int r, int h) { return (r & 3) + 8 * (r >> 2) + 4 * h; }
DI s16x4 vtr(const LAS unsigned char* p) { return __builtin_bit_cast(s16x4, __builtin_amdgcn_ds_read_tr16_b64_v4i16((LAS s16x4*)p)); }
DI bf16x8 packp(const f32x16& x, int s) {
    u32x4 w; w.x = cvtpk(x[8 * s], x[8 * s + 1]); w.y = cvtpk(x[8 * s + 2], x[8 * s + 3]); w.z = cvtpk(x[8 * s + 4], x[8 * s + 5]); w.w = cvtpk(x[8 * s + 6], x[8 * s + 7]);
    return __builtin_bit_cast(bf16x8, w);
}

template <int DQK, bool WIN>
DI void attn_run(int wv, const bf16_t* Qrow0, int qs, const bf16_t* Kb, int ks, const bf16_t* Vb, int vs,
                 int kt0, int kt1, int qpos0, int window, LAS unsigned char* lds, f32x16 (&o)[2], float& m_out, float& l_out) {
    constexpr int KP = DQK * 2 + 16, VP = 192  , KBYTES = 64 * KP, VBYTES = 64 * VP, BUF = KBYTES + VBYTES, NDS = DQK / 16, CPR = DQK / 8;
    const int tid = get_tid(wv), lane = tid & 63, r32 = lane & 31, h = lane >> 5;
    bf16x8 q[NDS];
    { const bf16_t* qp = Qrow0 + (size_t)r32 * qs + 8 * h;
#pragma unroll
      for (int ds = 0; ds < NDS; ++ds) q[ds] = __builtin_bit_cast(bf16x8, gld16(qp + 16 * ds)); }
    const int kr0 = tid / CPR, kc0 = tid % CPR;
    const int kr1 = (tid + 512) / CPR, kc1 = (tid + 512) % CPR;
    const bool k2 = (DQK == 96) && (tid < 256);
    const int vr = tid >> 3, vc = tid & 7;
    const bf16_t* kg0 = Kb + (size_t)kr0 * ks + kc0 * 8;
    const bf16_t* kg1 = Kb + (size_t)kr1 * ks + kc1 * 8;
    const bf16_t* vg = Vb + (size_t)vr * vs + vc * 8;
    const int kl0 = kr0 * KP + kc0 * 16, kl1 = kr1 * KP + kc1 * 16, vl = KBYTES + vr * VP + vc * 16;
    const int kfo = r32 * KP + h * 16;
    const int i16 = lane & 15, qq = i16 >> 2, pp = i16 & 3, blk = (lane >> 4) & 1;
    const int vfo = KBYTES + (4 * h + qq) * VP + 32 * blk + 8 * pp;
#pragma unroll
    for (int i = 0; i < 16; ++i) { o[0][i] = 0.f; o[1][i] = 0.f; }
    float mrun = 0.f, lrun = 0.f; bool first = true;
    f32x16 negm;
#pragma unroll
    for (int i = 0; i < 16; ++i) negm[i] = 0.f;
#define ATTN_BAR() asm volatile("s_waitcnt lgkmcnt(0)\n\ts_barrier" ::: "memory")
    u32x4 rk0, rk1 = (u32x4){0u, 0u, 0u, 0u}, rv;
    u32x4 nk0, nk1 = (u32x4){0u, 0u, 0u, 0u}, nv;
    { const size_t ko = (size_t)kt0 * 64 * ks, vo = (size_t)kt0 * 64 * vs;
      rk0 = gld16(kg0 + ko); if (k2) rk1 = gld16(kg1 + ko); rv = gld16(vg + vo);
      *(LAS u32x4*)(lds + kl0) = rk0; if (k2) *(LAS u32x4*)(lds + kl1) = rk1; *(LAS u32x4*)(lds + vl) = rv; }
    if (kt0 + 1 < kt1) { const size_t ko = (size_t)(kt0 + 1) * 64 * ks, vo = (size_t)(kt0 + 1) * 64 * vs;
      rk0 = gld16(kg0 + ko); if (k2) rk1 = gld16(kg1 + ko); rv = gld16(vg + vo); }
    nk0 = rk0; nv = rv;
    ATTN_BAR();
    for (int kt = kt0; kt < kt1; ++kt) {
        const int buf = (kt - kt0) & 1;
        const bool more = (kt + 1 < kt1);
        if (kt + 2 < kt1) { const size_t ko = (size_t)(kt + 2) * 64 * ks, vo = (size_t)(kt + 2) * 64 * vs;
            nk0 = gld16(kg0 + ko); if (k2) nk1 = gld16(kg1 + ko); nv = gld16(vg + vo); }
        bool need = true;
        if (WIN) need = (64 * kt + 63 >= qpos0 - window) && (64 * kt <= qpos0 + 31 + window);
        if (need) {
            const LAS unsigned char* base = lds + buf * BUF;
            bf16x8 kf0[NDS], kf1[NDS];
#pragma unroll
            for (int ds = 0; ds < NDS; ++ds) {
                kf0[ds] = *(const LAS bf16x8*)(base + kfo + ds * 32);
                kf1[ds] = *(const LAS bf16x8*)(base + kfo + 32 * KP + ds * 32);
            }
            __builtin_amdgcn_s_setprio(1);
            f32x16 p0 = __builtin_amdgcn_mfma_f32_32x32x16_bf16(kf0[0], q[0], negm, 0, 0, 0);
            f32x16 p1 = __builtin_amdgcn_mfma_f32_32x32x16_bf16(kf1[0], q[0], negm, 0, 0, 0);
#pragma unroll
            for (int ds = 1; ds < NDS; ++ds) {
                p0 = __builtin_amdgcn_mfma_f32_32x32x16_bf16(kf0[ds], q[ds], p0, 0, 0, 0);
                p1 = __builtin_amdgcn_mfma_f32_32x32x16_bf16(kf1[ds], q[ds], p1, 0, 0, 0);
            }
            __builtin_amdgcn_s_setprio(0);
            s16x4 vlo[4][2], vhi[4][2];
#pragma unroll
            for (int k4 = 0; k4 < 4; ++k4)
#pragma unroll
                for (int db = 0; db < 2; ++db) {
                    vlo[k4][db] = vtr(base + vfo + (16 * k4) * VP + 64 * db);
                    vhi[k4][db] = vtr(base + vfo + (16 * k4 + 8) * VP + 64 * db);
                }
            if (WIN) {
                const int qp_ = qpos0 + r32, kb_ = 64 * kt + 4 * h;
#pragma unroll
                for (int r = 0; r < 16; ++r) {
                    const int kk = kb_ + (r & 3) + 8 * (r >> 2);
                    int d0 = qp_ - kk; d0 = d0 < 0 ? -d0 : d0;
                    int d1 = qp_ - kk - 32; d1 = d1 < 0 ? -d1 : d1;
                    if (d0 > window) p0[r] = -1e30f;
                    if (d1 > window) p1[r] = -1e30f;
                }
            }
            float mxa = max3f(p0[0], p0[1], p1[0]), mxb = max3f(p0[2], p0[3], p1[1]);
            mxa = max3f(mxa, p1[2], p1[3]);
#pragma unroll
            for (int r = 4; r < 16; r += 4) { mxa = max3f(mxa, p0[r], p0[r + 1]); mxb = max3f(mxb, p0[r + 2], p0[r + 3]); mxa = max3f(mxa, p1[r], p1[r + 1]); mxb = max3f(mxb, p1[r + 2], p1[r + 3]); }
            float mx = max3f(mxa, mxb, mxb);
            mx = max3f(mx, shx(mx, 32), mx);
            if (first || __any(mx > 8.0f)) {
                const float d = first ? (WIN ? fmaxf(mx, -1e20f) : mx) : fmaxf(mx, 0.f);
                const float alpha = first ? 1.f : fexp2(-d);
                mrun += d;
                first = false;
#pragma unroll
                for (int i = 0; i < 16; ++i) { negm[i] = -mrun; p0[i] -= d; p1[i] -= d; o[0][i] *= alpha; o[1][i] *= alpha; }
                lrun *= alpha;
            }
            float ls = 0.f;
#pragma unroll
            for (int r = 0; r < 16; ++r) { p0[r] = fexp2(p0[r]); p1[r] = fexp2(p1[r]); ls += p0[r] + p1[r]; }
            lrun += ls;
#pragma unroll
            for (int k4 = 0; k4 < 4; ++k4) {
                const bf16x8 pf = packp((k4 < 2) ? p0 : p1, k4 & 1);
#pragma unroll
                for (int db = 0; db < 2; ++db) {
                    const bf16x8 vf = __builtin_shufflevector(vlo[k4][db], vhi[k4][db], 0, 1, 2, 3, 4, 5, 6, 7);
                    o[db] = __builtin_amdgcn_mfma_f32_32x32x16_bf16(vf, pf, o[db], 0, 0, 0);
                }
            }
        }
        if (more) { LAS unsigned char* nb = lds + (buf ^ 1) * BUF;
            *(LAS u32x4*)(nb + kl0) = rk0; if (k2) *(LAS u32x4*)(nb + kl1) = rk1; *(LAS u32x4*)(nb + vl) = rv; }
        ATTN_BAR();
        rk0 = nk0; rk1 = nk1; rv = nv;
    }
    m_out = mrun; l_out = lrun + shx(lrun, 32);
}

constexpr int ATTN_STAGE_OFF = 53248, ATTN_STAGE_WAVE = 32 * 144;
DI void attn_store(const f32x16 (&o)[2], float inv, bf16_t* d0, int dstride, const bf16_t* g0, int gstride, int lane, LAS unsigned char* stage) {
    const int r32 = lane & 31, h = lane >> 5;
#pragma unroll
    for (int db = 0; db < 2; ++db)
#pragma unroll
        for (int g = 0; g < 4; ++g) {
            const int d = 32 * db + 8 * g + 4 * h;
            u32x2 w; w.x = cvtpk(o[db][4 * g] * inv, o[db][4 * g + 1] * inv); w.y = cvtpk(o[db][4 * g + 2] * inv, o[db][4 * g + 3] * inv);
            *(LAS u32x2*)(stage + r32 * 144 + d * 2) = w;
        }
    asm volatile("s_waitcnt lgkmcnt(0)" ::: "memory");
    const int row = lane >> 1, half = lane & 1;
    u32x4 v[4];
#pragma unroll
    for (int i = 0; i < 4; ++i) v[i] = *(const LAS u32x4*)(stage + row * 144 + half * 64 + 16 * i);
    if (g0) {
        const bf16_t* gp = g0 + (size_t)row * gstride + half * 32;
#pragma unroll
        for (int i = 0; i < 4; ++i) {
            const u32x4 z = gld16(gp + 8 * i);
#pragma unroll
            for (int k = 0; k < 4; ++k) v[i][k] = cvtpk(bflo(v[i][k]) * bflo(z[k]), bfhi(v[i][k]) * bfhi(z[k]));
        }
    }
    bf16_t* dp = d0 + (size_t)row * dstride + half * 32;
#pragma unroll
    for (int i = 0; i < 4; ++i) *(u32x4*)(dp + 8 * i) = v[i];
    asm volatile("s_waitcnt lgkmcnt(0)" ::: "memory");
}

DI void phase_attn(int wv, const Params& p, int layer, LAS unsigned char* lds) {
    unsigned char* ws = launder(p.ws); const int S = launder(p.spc); const size_t Mc = (size_t)S * T; const WS w = make_ws(Mc);
    const int tidl = get_tid(wv); const int wave = __builtin_amdgcn_readfirstlane(tidl >> 6), lane = tidl & 63, r32 = lane & 31, h = lane >> 5;
    const int nA = S * 32, nB = S * 32, nC = S * 32, nD = S * 96, ntot = nA + nB + nC + nD;
    bf16_t* YG = (bf16_t*)(ws + w.YG); const bf16_t* ZS = (const bf16_t*)(ws + w.ZS);
    LAS unsigned char* stage = lds + ATTN_STAGE_OFF + wave * ATTN_STAGE_WAVE;
#ifndef ATTN_TYPES
#define ATTN_TYPES 15
#endif
    const int Gb = gridDim.x, vcu = (Gb % 8 == 0) ? ((int)blockIdx.x % 8) * (Gb / 8) + (int)blockIdx.x / 8 : (int)blockIdx.x;
    for (int it = vcu; it < ntot; it += Gb) {
        f32x16 o[2]; float mr, lr;
        { const int ty = (it < nA) ? 1 : (it < nA + nB) ? 2 : (it < nA + nB + nC) ? 4 : 8; if (!(ATTN_TYPES & ty)) continue; }
        if (it < nA) {
            const int b = it >> 5, rem = it & 31, head = rem >> 3, qt = rem & 7;
            const int t0 = 256 * qt + 32 * wave; const size_t row0 = (size_t)b * T;
            const bf16_t* Q = (const bf16_t*)(ws + w.QA) + ((row0 + t0) * 4 + head) * 96;
            const bf16_t* K = (const bf16_t*)(ws + w.KA) + (row0 * 4 + head) * 96;
            const bf16_t* V = (const bf16_t*)(ws + w.VA) + (row0 * 4 + head) * 64;
            attn_run<96, false>(wv, Q, 384, K, 384, V, 256, 0, 32, 0, 0, lds, o, mr, lr);
            const size_t rw0 = row0 + t0;
            attn_store(o, __builtin_amdgcn_rcpf(lr), YG + rw0 * 256 + head * 64, 256, ZS + rw0 * 1024 + head * 64, 1024, lane, stage);
        } else if (it < nA + nB + nC) {
            const bool isC = it >= nA + nB;
            const int i2 = it - nA - (isC ? nB : 0);
            const int b = i2 >> 5, rem = i2 & 31, kvh = rem >> 4, qt = rem & 15;
            const int qh = 2 * kvh + (wave >> 2), t0 = 128 * qt + 32 * (wave & 3); const size_t row0 = (size_t)b * T;
            const bf16_t* Q = (const bf16_t*)(ws + (isC ? w.QC : w.QB)) + ((row0 + t0) * 4 + qh) * 64;
            const bf16_t* K = (const bf16_t*)(ws + (isC ? w.KC : w.KB)) + (row0 * 2 + kvh) * 64;
            const bf16_t* V = (const bf16_t*)(ws + (isC ? w.VC : w.VB)) + (row0 * 2 + kvh) * 64;
            const size_t rw0 = row0 + t0;
            if (!isC) {
                attn_run<64, false>(wv, Q, 256, K, 128, V, 128, 0, 32, 0, 0, lds, o, mr, lr);
                attn_store(o, __builtin_amdgcn_rcpf(lr), YG + (Mc + rw0) * 256 + qh * 64, 256, ZS + rw0 * 1024 + 256 + qh * 64, 1024, lane, stage);
            } else {
                int k0 = 2 * qt - 2, k1 = 2 * qt + 4; if (k0 < 0) k0 = 0; if (k1 > 32) k1 = 32;
                attn_run<64, true>(wv, Q, 256, K, 128, V, 128, k0, k1, t0, 128, lds, o, mr, lr);
                const float sink = p.in[10][layer * 4 + qh];
                const float lt = lr + fexp2(sink * LOG2E - mr);
                attn_store(o, __builtin_amdgcn_rcpf(lt), YG + (2 * Mc + rw0) * 256 + qh * 64, 256, ZS + rw0 * 1024 + 512 + qh * 64, 1024, lane, stage);
            }
        } else {
            const int i2 = it - nA - nB - nC;
            const int b = i2 / 96, rem = i2 % 96, g = rem >> 5, rem2 = rem & 31, kvh = rem2 >> 4, qt = rem2 & 15;
            const int Ls = 2048 >> (2 * g);
            const int tp0 = 128 * qt, sb = tp0 & ~(Ls - 1), u0 = tp0 - sb;
            const int qh = 2 * kvh + (wave >> 2), wq = 32 * (wave & 3); const size_t row0 = (size_t)b * T;
            const bf16_t* Q = (const bf16_t*)(ws + w.QD) + (size_t)g * Mc * 256 + ((row0 + tp0 + wq) * 4 + qh) * 64;
            const bf16_t* K = (const bf16_t*)(ws + w.KD) + (size_t)g * Mc * 128 + ((row0 + sb) * 2 + kvh) * 64;
            const bf16_t* V = (const bf16_t*)(ws + w.VD) + (size_t)g * Mc * 128 + ((row0 + sb) * 2 + kvh) * 64;
            int k0 = (u0 >> 6) - 1, k1 = (u0 >> 6) + 3; if (k0 < 0) k0 = 0; if (k1 > (Ls >> 6)) k1 = (Ls >> 6);
            attn_run<64, true>(wv, Q, 256, K, 128, V, 128, k0, k1, u0 + wq, 64, lds, o, mr, lr);
            const size_t rw0 = row0 + tp0 + wq; const size_t row = rw0 + r32;
            attn_store(o, __builtin_amdgcn_rcpf(lr), (bf16_t*)(ws + w.OD) + (size_t)g * Mc * 256 + rw0 * 256 + qh * 64, 256, nullptr, 0, lane, stage);
            if (h == 0) ((float*)(ws + w.LSE))[(size_t)g * Mc * 4 + row * 4 + qh] = mr + __builtin_amdgcn_logf(lr);
        }
    }
}

DI void phase_dcombine(int wv, const Params& p) {
    unsigned char* ws = launder(p.ws); const int S = launder(p.spc); const size_t Mc = (size_t)S * T; const WS w = make_ws(Mc);
    const bf16_t* OD = (const bf16_t*)(ws + w.OD); const float* LSE = (const float*)(ws + w.LSE);
    const bf16_t* ZS = (const bf16_t*)(ws + w.ZS); bf16_t* YG = (bf16_t*)(ws + w.YG) + 3 * Mc * 256;
    const size_t total = Mc * 32;
    for (size_t idx = (size_t)blockIdx.x * 512 + get_tid(wv); idx < total; idx += (size_t)gridDim.x * 512) {
        const size_t row = idx >> 5; const int hd = (int)(idx & 31), head = hd >> 3, c8 = hd & 7;
        const int pos = (int)(row & 2047); const size_t rb = row - pos;
        const size_t r1 = rb + ((pos & 3) << 9) + (pos >> 2), r2 = rb + ((pos & 15) << 7) + (pos >> 4);
        const float l0 = LSE[row * 4 + head], l1 = LSE[Mc * 4 + r1 * 4 + head], l2 = LSE[2 * Mc * 4 + r2 * 4 + head];
        const float mx = fmaxf(l0, fmaxf(l1, l2));
        float w0 = fexp2(l0 - mx), w1 = fexp2(l1 - mx), w2 = fexp2(l2 - mx);
        const float inv = __builtin_amdgcn_rcpf(w0 + w1 + w2); w0 *= inv; w1 *= inv; w2 *= inv;
        const u32x4 a = *(const u32x4*)(OD + row * 256 + head * 64 + c8 * 8);
        const u32x4 b = *(const u32x4*)(OD + Mc * 256 + r1 * 256 + head * 64 + c8 * 8);
        const u32x4 c = *(const u32x4*)(OD + 2 * Mc * 256 + r2 * 256 + head * 64 + c8 * 8);
        const u32x4 z = *(const u32x4*)(ZS + row * 1024 + 768 + head * 64 + c8 * 8);
        u32x4 r;
#pragma unroll
        for (int i = 0; i < 4; ++i) {
            const float lo = (w0 * bflo(a[i]) + w1 * bflo(b[i]) + w2 * bflo(c[i])) * bflo(z[i]);
            const float hi = (w0 * bfhi(a[i]) + w1 * bfhi(b[i]) + w2 * bfhi(c[i])) * bfhi(z[i]);
            r[i] = cvtpk(lo, hi);
        }
        *(u32x4*)(YG + row * 256 + head * 64 + c8 * 8) = r;
    }
}


#define XB_TMO      128
#define XB_XCNT(j)  (256  + 64 * (j))
#define XB_XSUB(j)  (1280 + 64 * (j))
#define XB_XGEN(j)  (2304 + 64 * (j))
#define XB_TOP      3328
#define XB_TOPGEN   3392
#define XCD_BAR_WORDS 3456
#define XB_SPIN_CAP (1u << 20)
DI unsigned xb_ld(unsigned* p) { return __hip_atomic_load(p, __ATOMIC_RELAXED, __HIP_MEMORY_SCOPE_AGENT); }
DI unsigned xb_add(unsigned* p, unsigned v) { return __hip_atomic_fetch_add(p, v, __ATOMIC_RELAXED, __HIP_MEMORY_SCOPE_AGENT); }
DI unsigned xb_xcc_id() { return (unsigned)__builtin_amdgcn_s_getreg((3 << 11) | 20) & 0xFu; }
#define XB_SPIN(cond, bar) do { unsigned _sp = 0; while (cond) { __builtin_amdgcn_s_sleep(1); \
    if ((++_sp & 255u) == 0u) { if (xb_ld(&(bar)[XB_TMO])) break; if (_sp > XB_SPIN_CAP) { atomicAdd(&(bar)[XB_TMO], 1u); break; } } } } while (0)
DI void xcd_barrier_complete(unsigned* bar, unsigned x, unsigned& nloc, unsigned& nx) {
    const unsigned G = gridDim.x;
    unsigned sum, cnt, mine, sp = 0u;
    for (;;) {
        sum = 0u; cnt = 0u; mine = 0u;
#pragma unroll
        for (unsigned j = 0; j < 16; ++j) { const unsigned c = xb_ld(&bar[XB_XCNT(j)]); sum += c; cnt += (c > 0u) ? 1u : 0u; mine = (j == x) ? c : mine; }
        if (sum == G) break;
        __builtin_amdgcn_s_sleep(1);
        if ((++sp & 255u) == 0u) { if (xb_ld(&bar[XB_TMO])) break; if (sp > XB_SPIN_CAP) { atomicAdd(&bar[XB_TMO], 1u); break; } }
    }
    nloc = mine > 0u ? mine : 1u; nx = cnt > 0u ? cnt : 1u;
}
DI void xcd_barrier(int wv, unsigned* bar0, volatile LAS unsigned* st) {
    asm volatile("s_waitcnt vmcnt(0)" ::: "memory");
    __syncthreads();
    if (get_tid(wv) == 0) {
        unsigned* bar = launder(bar0);
        const unsigned x = xb_xcc_id();
        __builtin_amdgcn_s_waitcnt(0);
        unsigned nloc = st[0], nx = st[1];
        if (nloc == 0u) { xcd_barrier_complete(bar, x, nloc, nx); st[0] = nloc; st[1] = nx; }
        const unsigned old = xb_add(&bar[XB_XSUB(x)], 1u);
        const unsigned gen = old / nloc;
        if (old + 1u == (gen + 1u) * nloc) {
            __builtin_amdgcn_fence(__ATOMIC_RELEASE, "agent");
            asm volatile("s_waitcnt vmcnt(0)" ::: "memory");
            const unsigned og = xb_add(&bar[XB_TOP], 1u);
            const unsigned tg = og / nx;
            if (og + 1u == (tg + 1u) * nx) xb_add(&bar[XB_TOPGEN], 1u);
            else XB_SPIN(xb_ld(&bar[XB_TOPGEN]) == tg, bar);
            __builtin_amdgcn_fence(__ATOMIC_ACQUIRE, "agent");
            xb_add(&bar[XB_XGEN(x)], 1u);
            asm volatile("s_waitcnt vmcnt(0)" ::: "memory");
        } else {
            XB_SPIN(xb_ld(&bar[XB_XGEN(x)]) == gen, bar);
            __builtin_amdgcn_fence(__ATOMIC_ACQUIRE, "agent");
            asm volatile("s_waitcnt vmcnt(0)" ::: "memory");
        }
    }
    __syncthreads();
}

__global__ void __launch_bounds__(512) mega_fwd(Params p) {
    extern __shared__ __attribute__((aligned(16))) unsigned char lds_raw[];
    LAS unsigned char* lds = (LAS unsigned char*)lds_raw;
    cg::grid_group grid = cg::this_grid();
    const int G = gridDim.x, c = blockIdx.x;
    const int wv = __builtin_amdgcn_readfirstlane((int)threadIdx.x >> 6);
    volatile LAS unsigned* bst = (volatile LAS unsigned*)(lds + 131072);
    unsigned* bar0;
    { const WS w0 = make_ws((size_t)p.spc * T); bar0 = (unsigned*)(p.ws + w0.END);
      if (threadIdx.x == 0) { bst[0] = 0u; bst[1] = 0u; (void)xb_add(&bar0[XB_XCNT(xb_xcc_id())], 1u); } }
    __syncthreads();
#define GSYNC() xcd_barrier(wv, bar0, bst)

#ifndef STOPAT
#define STOPAT 99
#endif
    phase0(wv, p, lds);
    grid.sync();
    if (STOPAT == 0) return;

    for (int ch = 0; ch < p.nchunk; ++ch) {
        for (int l = 0; l < 2; ++l) {
#define ROWS() const size_t grow0 = (size_t)ch * Mc; float* outb = launder(p.out); float* outc = outb + grow0 * 1024; \
            const float* xa = launder((l == 0) ? p.in[0] : (const float*)outb); const float* xb2 = launder(p.in[1]); const size_t split = (l == 0) ? (size_t)PROMPT_ROWS : ~(size_t)0; (void)outc
            { CTX(); ROWS(); phase_prep(wv, xa, xb2, split, grow0, (bf16_t*)(ws + w.XB), Mc); }
            GSYNC();
            if (STOPAT == 1) return;
            { CTX();
              pg8::Gemm g{(const bf16_t*)(ws + w.XB), (const bf16_t*)(ws + w.WinT) + (size_t)l * 4096 * 1024, 1024, 0, 0};
              pg8::Order O; O.init(Mc, 4096, 1, G, c);
              Epi1 E{ws, p.in[8] + l * 64, p.in[9] + l * 64, (size_t)Mc};
              pg8::gemm_phase(wv, lds, g, O, E); }
            GSYNC();
            if (STOPAT == 2) return;
            { CTX();
              pg8::Gemm g{(const bf16_t*)(ws + w.LAT), (const bf16_t*)(ws + w.WupT) + (size_t)l * 1024 * 384, 384, 0, 0};
              pg8::Order O; O.init(Mc, 1024, 1, G, c);
              Epi3 E{(bf16_t*)(ws + w.QA), (bf16_t*)(ws + w.KA), (bf16_t*)(ws + w.VA), (const float*)(ws + w.SSQ)};
              pg8::gemm_phase(wv, lds, g, O, E); }
            GSYNC();
            if (STOPAT == 3) return;
            phase_attn(wv, p, l, lds);
            GSYNC();
            if (STOPAT == 4) return;
            phase_dcombine(wv, p);
            GSYNC();
            if (STOPAT == 5) return;
#define RUN_P6A(SUB) { CTX(); const int Ms = Mc / NSUB; const size_t r0s = (size_t)(SUB) * Ms; \
                  pg8::Gemm g{(const bf16_t*)(ws + w.YG) + r0s * 256, (const bf16_t*)(ws + w.WbT) + (size_t)l * 4 * 1024 * 256, 256, (size_t)Mc * 512, (size_t)1024 * 256 * 2}; \
                  pg8::Order O; O.init(Ms, 1024, 4, G, c); \
                  Epi6a E{(bf16_t*)(ws + w.P) + (size_t)((SUB) & 1) * Ms * 4096}; \
                  pg8::gemm_phase(wv, lds, g, O, E); }
            RUN_P6A(0);
            GSYNC();
            for (int sub = 0; sub < NSUB; ++sub) {
                { CTX(); const int Ms = Mc / NSUB; const size_t r0s = (size_t)sub * Ms;
                  pg8::Gemm g{(const bf16_t*)(ws + w.XB) + r0s * 1024, (const bf16_t*)(ws + w.WmgT) + (size_t)l * 4096 * 1024, 1024, 0, 0};
                  pg8::Order O; O.init(Ms, 4096, 1, G, c);
                  Epi6b E{(const bf16_t*)(ws + w.P) + (size_t)(sub & 1) * Ms * 4096, (bf16_t*)(ws + w.MRG) + r0s * 1024};
                  pg8::gemm_phase(wv, lds, g, O, E); }
                if (sub + 1 < NSUB) RUN_P6A(sub + 1);
                GSYNC();
            }
            { CTX(); ROWS();
              pg8::Gemm g{(const bf16_t*)(ws + w.MRG), (const bf16_t*)(ws + w.WoutT) + (size_t)l * 1024 * 1024, 1024, 0, 0};
              pg8::Order O; O.init(Mc, 1024, 1, G, c);
              Epi7 E{xa, xb2, split, grow0, outc};
              pg8::gemm_phase(wv, lds, g, O, E); }
            GSYNC();
            if (STOPAT == 8) return;
        }
        { CTX(); const int l = 1; ROWS(); phase_final(wv, outc, p.in[13], Mc); }
    }
}

extern "C" void kernel_launch(void* const* d_in, const int* in_sizes, int n_in, void* d_out, int out_size, void* d_ws, size_t ws_size, hipStream_t stream) {
    constexpr int LDS_BYTES = 131072 + 256;
    static int grid_blocks = 0;
    if (!grid_blocks) {
        int dev = 0, cus = 0, per_cu = 0;
        hipGetDevice(&dev);
        hipDeviceGetAttribute(&cus, hipDeviceAttributeMultiprocessorCount, dev);
        hipFuncSetAttribute((const void*)mega_fwd, hipFuncAttributeMaxDynamicSharedMemorySize, LDS_BYTES);
        hipOccupancyMaxActiveBlocksPerMultiprocessor(&per_cu, (const void*)mega_fwd, 512, LDS_BYTES);
        if (per_cu < 1) per_cu = 1;
        grid_blocks = cus * per_cu;
    }
    Params p{};
    for (int i = 0; i < 14; ++i) p.in[i] = (const float*)d_in[i];
    p.out = (float*)d_out; p.ws = (unsigned char*)d_ws;
    int spc = 24;
    while (spc > 1 && make_ws((size_t)spc * T).END + XCD_BAR_WORDS * 4 > ws_size) { spc = (spc == 24) ? 16 : spc / 2; }
    p.spc = spc; p.nchunk = NSEQ / spc;
    (void)hipMemsetAsync((unsigned char*)d_ws + make_ws((size_t)spc * T).END, 0, XCD_BAR_WORDS * 4, stream);
    void* args[] = {&p};
    hipError_t e = hipLaunchCooperativeKernel((const void*)mega_fwd, dim3(grid_blocks), dim3(512), args, LDS_BYTES, stream);
    if (e != hipSuccess) fprintf(stderr, "cooperative launch failed: %s (grid %d)\n", hipGetErrorString(e), grid_blocks);
}
```
